# Optimizing an MI355X kernel written in HIP

```python
import jax, jax.numpy as jnp
from jax import lax
import numpy as np

D_MODEL = 1024
BATCH = 32
SEQ = 2048
DEPTH = 2

CHUNK = 64
Q_BLOCK = 128
N_BRANCH = 3

POOL_WINDOWS = (2, 4, 8, 16)
POOL_GROUPS = 4
POOL_WIDTH = D_MODEL
POOL_GW = POOL_WIDTH // POOL_GROUPS

MLA_HEADS = 8
QK_NOPE = 128
QK_ROPE = 64
V_DIM = 128
Q_LORA = D_MODEL // 4
KV_LORA = D_MODEL // 8
MLA_WIDTH = MLA_HEADS * V_DIM
ROPE_THETA = 10000.0

SG_WIDTH = D_MODEL
SG_BLOCK = 128
SG_GROUPS = 8
SG_GW = SG_WIDTH // SG_GROUPS

D_FF = 2816
CONV_W = 3

OFF_POOL = N_BRANCH * D_MODEL
OFF_CQ = OFF_POOL + POOL_WIDTH
OFF_CKV = OFF_CQ + Q_LORA
OFF_KR = OFF_CKV + KV_LORA
OFF_SG = OFF_KR + QK_ROPE
IN_WIDTH = OFF_SG + 2 * SG_WIDTH

ALPHA = (2 * DEPTH) ** 0.25
BETA = (8 * DEPTH) ** -0.25
LN_EPS = 1e-5
RMS_EPS = 1e-6

kernel_name = "hybrid_pool_mla_sgu_convffn_deepnorm"


def _layer_norm(x):
    xf = x.astype(jnp.float32)
    mu = jnp.mean(xf, axis=-1, keepdims=True)
    var = jnp.mean(jnp.square(xf - mu), axis=-1, keepdims=True)
    return ((xf - mu) * lax.rsqrt(var + LN_EPS)).astype(x.dtype)


def _rms_norm(x, g):
    xf = x.astype(jnp.float32)
    y = xf * lax.rsqrt(jnp.mean(jnp.square(xf), axis=-1, keepdims=True) + RMS_EPS)
    return y.astype(x.dtype) * g


def _rope_tables(pos):
    freqs = ROPE_THETA ** (-jnp.arange(0, QK_ROPE, 2, dtype=jnp.float32) / QK_ROPE)
    ang = pos.astype(jnp.float32)[..., None] * freqs
    return jnp.cos(ang), jnp.sin(ang)


def _apply_rope(x, cos, sin):
    xf = x.astype(jnp.float32)
    x1, x2 = jnp.split(xf, 2, axis=-1)
    out = jnp.concatenate([x1 * cos - x2 * sin, x2 * cos + x1 * sin], axis=-1)
    return out.astype(x.dtype)


def _modulate(x, shift, scale):
    return _layer_norm(x) * (1.0 + scale[:, None, :]) + shift[:, None, :]


def _pool_mixer(a, w_pool, s_pool):
    B, S, _ = a.shape
    af = a.astype(jnp.float32)
    cs = jnp.pad(jnp.cumsum(af, axis=1), ((0, 0), (1, 0), (0, 0)))
    outs = []
    for g, w in enumerate(POOL_WINDOWS):
        c_g = cs[..., g * POOL_GW:(g + 1) * POOL_GW]
        lag = jnp.pad(c_g, ((0, 0), (w, 0), (0, 0)))[:, :S + 1]
        cnt = jnp.minimum(jnp.arange(1, S + 1), w).astype(jnp.float32)[None, :, None]
        mean = (c_g[:, 1:] - lag[:, 1:]) / cnt
        outs.append(mean - af[..., g * POOL_GW:(g + 1) * POOL_GW])
    pooled = jnp.stack(outs, axis=2).astype(a.dtype)
    mixed = jnp.einsum('bsgc,gcd->bsgd', pooled, w_pool)
    return mixed.reshape(B, S, POOL_WIDTH) * s_pool


def _mla(cq, ckv, kr, cos, sin, g_q, w_uq, g_kv, w_ukv):
    B, S, _ = cq.shape
    q = jnp.einsum('bsr,rhd->bshd', _rms_norm(cq, g_q), w_uq)
    kv = jnp.einsum('bsr,rhd->bshd', _rms_norm(ckv, g_kv), w_ukv)
    q_nope, q_rope = q[..., :QK_NOPE], q[..., QK_NOPE:]
    k_nope, v = kv[..., :QK_NOPE], kv[..., QK_NOPE:]
    q_rope = _apply_rope(q_rope, cos[:, :, None, :], sin[:, :, None, :])
    k_rope = _apply_rope(kr, cos, sin)
    scale = (QK_NOPE + QK_ROPE) ** -0.5
    neg = jnp.finfo(jnp.float32).min
    outs = []
    for i in range(S // Q_BLOCK):
        q0, q1 = i * Q_BLOCK, (i + 1) * Q_BLOCK
        s = (jnp.einsum('bqhd,bkhd->bhqk', q_nope[:, q0:q1], k_nope[:, :q1])
             + jnp.einsum('bqhd,bkd->bhqk', q_rope[:, q0:q1], k_rope[:, :q1]))
        s = s.astype(jnp.float32) * scale
        qc = (q0 + jnp.arange(Q_BLOCK)) // CHUNK
        kc = jnp.arange(q1) // CHUNK
        s = jnp.where(kc[None, :] <= qc[:, None], s, neg)
        p = jax.nn.softmax(s, axis=-1).astype(v.dtype)
        outs.append(jnp.einsum('bhqk,bkhd->bqhd', p, v[:, :q1]))
    o = jnp.concatenate(outs, axis=1)
    return o.reshape(B, S, MLA_WIDTH)


def _sgu(uv, g_sg, b_sg, w_s, b_s):
    uv = jax.nn.gelu(uv, approximate=False)
    u, v = jnp.split(uv, 2, axis=-1)
    v = _layer_norm(v) * g_sg + b_sg
    B, S, _ = v.shape
    nb = S // SG_BLOCK
    v = v.reshape(B, nb, SG_BLOCK, SG_GROUPS, SG_GW)
    mask = jnp.tril(jnp.ones((SG_BLOCK, SG_BLOCK), dtype=bool))
    ws = jnp.where(mask[None], w_s, jnp.zeros_like(w_s))
    z = jnp.einsum('gts,bnsgc->bntgc', ws, v) + b_s[:, :, None]
    return u * z.reshape(B, S, SG_WIDTH)


def _token_mixer(h, cos, sin, w_in, w_pool, s_pool, g_q, w_uq, g_kv, w_ukv,
                 g_sg, b_sg, w_s, b_s, w_branch, w_o):
    B, S, _ = h.shape
    p = h @ w_in
    gates, a, cq, ckv, kr, uv = jnp.split(p, [OFF_POOL, OFF_CQ, OFF_CKV, OFF_KR, OFF_SG], axis=-1)
    gates = jax.nn.sigmoid(gates).reshape(B, S, N_BRANCH, D_MODEL)
    y_a = _pool_mixer(a, w_pool, s_pool) @ w_branch[0]
    y_b = _mla(cq, ckv, kr, cos, sin, g_q, w_uq, g_kv, w_ukv) @ w_branch[1]
    y_c = _sgu(uv, g_sg, b_sg, w_s, b_s) @ w_branch[2]
    merged = gates[:, :, 0] * y_a + gates[:, :, 1] * y_b + gates[:, :, 2] * y_c
    return merged @ w_o


def _conv_ffn(h, w_up, conv_w, conv_b, w_down):
    z = h @ w_up
    S = z.shape[1]
    zp = jnp.pad(z, ((0, 0), (CONV_W - 1, 0), (0, 0)))
    zc = conv_b + conv_w[0] * zp[:, 0:S]
    for k in range(1, CONV_W):
        zc = zc + conv_w[k] * zp[:, k:k + S]
    val, gate = jnp.split(zc, 2, axis=-1)
    return (jax.nn.silu(gate) * val) @ w_down


def setup_inputs(seed: int = 0) -> dict:
    key = jax.random.key(seed)
    ks = jax.random.split(key, 26)
    f32 = jnp.float32

    def nrm(k, shape, scale):
        return jax.random.normal(k, shape, f32) * scale

    L = DEPTH
    pos = (jax.random.randint(ks[2], (BATCH, 1), 0, 8192, dtype=jnp.int32)
           + jnp.arange(SEQ, dtype=jnp.int32)[None, :])
    return {
        "x": nrm(ks[0], (BATCH, SEQ, D_MODEL), 1.0),
        "c": nrm(ks[1], (BATCH, D_MODEL), 1.0),
        "pos": pos,
        "w_ada": nrm(ks[3], (L, D_MODEL, 6 * D_MODEL), 0.5 * D_MODEL ** -0.5),
        "b_ada": nrm(ks[4], (L, 6 * D_MODEL), 0.02),
        "w_in": nrm(ks[5], (L, D_MODEL, IN_WIDTH), D_MODEL ** -0.5),
        "w_pool": nrm(ks[6], (L, POOL_GROUPS, POOL_GW, POOL_GW), POOL_GW ** -0.5),
        "s_pool": 1.0 + nrm(ks[7], (L, POOL_WIDTH), 0.05),
        "g_q": 1.0 + nrm(ks[8], (L, Q_LORA), 0.05),
        "w_uq": nrm(ks[9], (L, Q_LORA, MLA_HEADS, QK_NOPE + QK_ROPE), Q_LORA ** -0.5),
        "g_kv": 1.0 + nrm(ks[10], (L, KV_LORA), 0.05),
        "w_ukv": nrm(ks[11], (L, KV_LORA, MLA_HEADS, QK_NOPE + V_DIM), KV_LORA ** -0.5),
        "g_sg": 1.0 + nrm(ks[12], (L, SG_WIDTH), 0.05),
        "b_sg": nrm(ks[13], (L, SG_WIDTH), 0.02),
        "w_s": nrm(ks[14], (L, SG_GROUPS, SG_BLOCK, SG_BLOCK), SG_BLOCK ** -0.5),
        "b_s": 1.0 + nrm(ks[15], (L, SG_BLOCK, SG_GROUPS), 0.02),
        "w_branch": nrm(ks[16], (L, N_BRANCH, D_MODEL, D_MODEL), D_MODEL ** -0.5),
        "w_o": nrm(ks[17], (L, D_MODEL, D_MODEL), BETA * D_MODEL ** -0.5),
        "ln_t_g": 1.0 + nrm(ks[18], (L, D_MODEL), 0.05),
        "ln_t_b": nrm(ks[19], (L, D_MODEL), 0.02),
        "w_up": nrm(ks[20], (L, D_MODEL, 2 * D_FF), D_MODEL ** -0.5),
        "conv_w": nrm(ks[21], (L, CONV_W, 2 * D_FF), CONV_W ** -0.5),
        "conv_b": nrm(ks[22], (L, 2 * D_FF), 0.02),
        "w_down": nrm(ks[23], (L, D_FF, D_MODEL), BETA * D_FF ** -0.5),
        "ln_f_g": 1.0 + nrm(ks[24], (L, D_MODEL), 0.05),
        "ln_f_b": nrm(ks[25], (L, D_MODEL), 0.02),
    }


def reference(x, c, pos, w_ada, b_ada, w_in, w_pool, s_pool, g_q, w_uq, g_kv, w_ukv,
              g_sg, b_sg, w_s, b_s, w_branch, w_o, ln_t_g, ln_t_b,
              w_up, conv_w, conv_b, w_down, ln_f_g, ln_f_b):
    cos, sin = _rope_tables(pos)
    c_act = jax.nn.silu(c)
    for l in range(DEPTH):
        mod = c_act @ w_ada[l] + b_ada[l]
        sh_t, sc_t, gt_t, sh_f, sc_f, gt_f = jnp.split(mod, 6, axis=-1)
        h = _modulate(x, sh_t, sc_t)
        y = _token_mixer(h, cos, sin, w_in[l], w_pool[l], s_pool[l], g_q[l], w_uq[l],
                         g_kv[l], w_ukv[l], g_sg[l], b_sg[l], w_s[l], b_s[l],
                         w_branch[l], w_o[l])
        x = _layer_norm(ALPHA * x + gt_t[:, None, :] * y) * ln_t_g[l] + ln_t_b[l]
        h = _modulate(x, sh_f, sc_f)
        y = _conv_ffn(h, w_up[l], conv_w[l], conv_b[l], w_down[l])
        x = _layer_norm(ALPHA * x + gt_f[:, None, :] * y) * ln_f_g[l] + ln_f_b[l]
    return x
```

```cpp
#include <hip/hip_runtime.h>
#include <hip/hip_cooperative_groups.h>
#include <cstdio>
#include <cstdint>
namespace cg = cooperative_groups;
namespace pg8 {
#define PG8_LAS __attribute__((address_space(3)))
typedef unsigned short bf16_t;
typedef short bf16x8 __attribute__((ext_vector_type(8)));
typedef float f32x4 __attribute__((ext_vector_type(4)));
typedef unsigned u32x4 __attribute__((ext_vector_type(4)));
constexpr int BM = 256, BK = 64, HALF = 128, HTB = HALF * BK * 2  , STAGE_BYTES = 8 * HTB, NXCD = 8, WGM = 8;

__host__ __device__ __forceinline__ int lds_byte(int r, int c) { const int st = (r >> 4) * 2 + (c >> 5), rr = r & 15, cc = c & 31, ob = rr * 64 + cc * 2; return st * 1024 + (ob ^ (((ob >> 9) & 1) << 5)); }
__host__ __device__ __forceinline__ void stage_rc(int b, int& R, int& C) { const int st = b / 1024, sb = b % 1024, swz = sb ^ (((sb >> 9) & 1) << 5); R = (st >> 1) * 16 + swz / 64; C = (st & 1) * 32 + (swz % 64) / 2; }
__host__ __device__ __forceinline__ int perm32(int rho) { const int n = rho >> 4, i = rho & 15; return 8 * (i >> 2) + 4 * n + (i & 3); }

struct Unit { int pm, pn; };
struct Gemm { const bf16_t* A; const bf16_t* Bt; int M, N, K; };

struct StaticOrder {
    int nM, nN, nwg, G, c;
    __host__ __device__ void init(int M, int N, int G_, int c_) { nM = M / BM; nN = N / BM; nwg = nM * nN; G = G_; c = c_; }
    __host__ __device__ bool next(int i, Unit& u) const {
        const long L = (long)i * G + c; if (L >= nwg) return false;
        int wgid = (int)L; { const int q = nwg / NXCD, r = nwg % NXCD, xcd = wgid % NXCD, off = wgid / NXCD; wgid = (xcd < r ? xcd * (q + 1) : r * (q + 1) + (xcd - r) * q) + off; }
        const int nig = WGM * nN, gid = wgid / nig, fm = gid * WGM, gsz = (nM - fm) < WGM ? (nM - fm) : WGM;
        u.pm = fm + ((wgid % nig) % gsz); u.pn = (wgid % nig) / gsz; return true;
    }
    __device__ __forceinline__ void a_ready(const Unit&) const {}
    __device__ __forceinline__ void done(const Unit&) const {}
};


typedef float f32x2 __attribute__((ext_vector_type(2)));
typedef __bf16 bfv2 __attribute__((ext_vector_type(2)));
typedef unsigned u32x2 __attribute__((ext_vector_type(2)));
__device__ __forceinline__ unsigned pk2(float a, float b) { f32x2 v = {a, b}; bfv2 r = __builtin_convertvector(v, bfv2); return __builtin_bit_cast(unsigned, r); }
__device__ __forceinline__ float bf_lo(unsigned w) { return __uint_as_float(w << 16); }
__device__ __forceinline__ float bf_hi(unsigned w) { return __uint_as_float(w & 0xffff0000u); }
__device__ __forceinline__ u32x4 pack8(const f32x4 a, const f32x4 b) { u32x4 w; w.x = pk2(a[0], a[1]); w.y = pk2(a[2], a[3]); w.z = pk2(b[0], b[1]); w.w = pk2(b[2], b[3]); return w; }
__device__ __forceinline__ f32x2 gelu_pk(f32x2 v) {
    const f32x2 av = __builtin_elementwise_abs(v), d = av * 0.2316418882f + 1.0f;
    f32x2 t; t.x = __builtin_amdgcn_rcpf(d.x); t.y = __builtin_amdgcn_rcpf(d.y);
    f32x2 q = t * 0.5307027145f + (-0.7265760135f); q = q * t + 0.7107068705f; q = q * t + (-0.142248368f); q = q * t + 0.127414796f; q = q * t;
    const f32x2 s = (v * v) * (-0.72134752044f);
    f32x2 e; e.x = __builtin_amdgcn_exp2f(s.x); e.y = __builtin_amdgcn_exp2f(s.y);
    const f32x2 m = v * (q * e), r = v - m;
    f32x2 o; o.x = v.x < 0.f ? m.x : r.x; o.y = v.y < 0.f ? m.y : r.y; return o;
}
__device__ __forceinline__ f32x4 gelu4(f32x4 v) { const f32x2 a = gelu_pk((f32x2){v[0], v[1]}), b = gelu_pk((f32x2){v[2], v[3]}); return (f32x4){a.x, a.y, b.x, b.y}; }
__device__ __forceinline__ float sigm(float x) { return __builtin_amdgcn_rcpf(1.0f + __builtin_amdgcn_exp2f(-1.4426950408889634f * x)); }
__device__ __forceinline__ f32x4 sigm4(f32x4 v) { return (f32x4){sigm(v[0]), sigm(v[1]), sigm(v[2]), sigm(v[3])}; }

struct Epi1 {
    static constexpr bool PERM = true, AFTER_DRAIN = false;
    bf16_t* gates; bf16_t* apool; bf16_t* uv; float* raw;
    __device__ __forceinline__ void operator()(const f32x4 (&acc)[2][2][4][2], const Unit& u, int wr, int wc, int fr, int fq) const {
        const int row0 = u.pm * BM + wr * 64 + fr, cl = wc * 32 + 8 * fq, pn = u.pn;
        if (pn < 24) {
            bf16_t* base; int ldc, col0, act;
            if (pn < 12) { base = gates; ldc = 3072; col0 = pn * 256; act = 1; }
            else if (pn < 16) { base = apool; ldc = 1024; col0 = (pn - 12) * 256; act = 0; }
            else { base = uv; ldc = 2048; col0 = (pn - 16) * 256; act = 2; }
#pragma unroll
            for (int ai = 0; ai < 2; ++ai)
#pragma unroll
                for (int m = 0; m < 4; ++m) { bf16_t* rowp = base + (size_t)(row0 + ai * HALF + m * 16) * ldc + col0 + cl;
#pragma unroll
                    for (int bj = 0; bj < 2; ++bj) { f32x4 v0 = acc[ai][bj][m][0], v1 = acc[ai][bj][m][1];
                        if (act == 1) { v0 = sigm4(v0); v1 = sigm4(v1); }
                        else if (act == 2) { v0 = gelu4(v0); v1 = gelu4(v1); }
                        *(u32x4*)(rowp + bj * HALF) = pack8(v0, v1); } }
        } else {
            float* base = raw + (pn - 24) * 256 + cl;
#pragma unroll
            for (int ai = 0; ai < 2; ++ai)
#pragma unroll
                for (int m = 0; m < 4; ++m) { float* rowp = base + (size_t)(row0 + ai * HALF + m * 16) * 512;
#pragma unroll
                    for (int bj = 0; bj < 2; ++bj) { *(f32x4*)(rowp + bj * HALF) = acc[ai][bj][m][0]; *(f32x4*)(rowp + bj * HALF + 4) = acc[ai][bj][m][1]; } }
        }
    }
};
struct EpiQ {
    static constexpr bool PERM = true, AFTER_DRAIN = false;
    bf16_t* qp; const float* cosT; const float* sinT; int tok0;
    __device__ __forceinline__ void operator()(const f32x4 (&acc)[2][2][4][2], const Unit& u, int wr, int wc, int fr, int fq) const {
        const float SC = 0.10411754627697264f;
        const int row0 = u.pm * BM + wr * 64 + fr;
        if (u.pn < 4) {
#pragma unroll
            for (int ai = 0; ai < 2; ++ai)
#pragma unroll
                for (int m = 0; m < 4; ++m) { bf16_t* rowp = qp + (size_t)(row0 + ai * HALF + m * 16) * 1536 + wc * 32 + 8 * fq;
#pragma unroll
                    for (int bj = 0; bj < 2; ++bj) *(u32x4*)(rowp + (2 * u.pn + bj) * 192) = pack8(acc[ai][bj][m][0] * SC, acc[ai][bj][m][1] * SC); }
        } else {
            const int h = 4 * (u.pn - 4) + wc;
#pragma unroll
            for (int ai = 0; ai < 2; ++ai)
#pragma unroll
                for (int m = 0; m < 4; ++m) { const int row = row0 + ai * HALF + m * 16;
#pragma unroll
                    for (int n = 0; n < 2; ++n) { const int i0 = 8 * fq + 4 * n; const size_t tr = (size_t)(tok0 + row) * 32 + i0;
                        const f32x4 c0 = *(const f32x4*)(cosT + tr) * SC, s0 = *(const f32x4*)(sinT + tr) * SC, x1 = acc[ai][0][m][n], x2 = acc[ai][1][m][n];
                        const f32x4 o1 = x1 * c0 - x2 * s0, o2 = x2 * c0 + x1 * s0;
                        bf16_t* rowp = qp + (size_t)row * 1536 + h * 192 + 128 + i0;
                        u32x2 w1; w1.x = pk2(o1[0], o1[1]); w1.y = pk2(o1[2], o1[3]); u32x2 w2; w2.x = pk2(o2[0], o2[1]); w2.y = pk2(o2[2], o2[3]);
                        *(u32x2*)(rowp) = w1; *(u32x2*)(rowp + 32) = w2; }
                    asm volatile("" ::: "memory"); }
        }
    }
};
struct EpiBr {
    static constexpr bool PERM = true, AFTER_DRAIN = false;
    const bf16_t* gates; float* part; bf16_t* merged; int nM;
    __device__ __forceinline__ void operator()(const f32x4 (&acc)[2][2][4][2], const Unit& u, int wr, int wc, int fr, int fq) const {
        const int br = u.pn >> 2, pn = u.pn & 3, pm = u.pm - br * nM;
        const int row0 = pm * BM + wr * 64 + fr, cl = pn * 256 + wc * 32 + 8 * fq;
#pragma unroll
        for (int ai = 0; ai < 2; ++ai)
#pragma unroll
            for (int m = 0; m < 4; ++m) { const size_t row = (size_t)(row0 + ai * HALF + m * 16);
#pragma unroll
                for (int bj = 0; bj < 2; ++bj) { const int col = cl + bj * HALF;
                    const u32x4 gw = *(const u32x4*)(gates + row * 3072 + br * 1024 + col);
                    f32x4 v0 = acc[ai][bj][m][0] * (f32x4){bf_lo(gw.x), bf_hi(gw.x), bf_lo(gw.y), bf_hi(gw.y)};
                    f32x4 v1 = acc[ai][bj][m][1] * (f32x4){bf_lo(gw.z), bf_hi(gw.z), bf_lo(gw.w), bf_hi(gw.w)};
                    float* pp = part + row * 1024 + col;
                    if (br == 0) { *(f32x4*)pp = v0; *(f32x4*)(pp + 4) = v1; }
                    else { v0 += *(const f32x4*)pp; v1 += *(const f32x4*)(pp + 4);
                        if (br == 1) { *(f32x4*)pp = v0; *(f32x4*)(pp + 4) = v1; }
                        else *(u32x4*)(merged + row * 1024 + col) = pack8(v0, v1); } } }
    }
};
struct EpiRes {
    static constexpr bool PERM = false, AFTER_DRAIN = false;
    const float* xin; float* xout; const float* gate; int tok0;
    __device__ __forceinline__ void operator()(const f32x4 (&acc)[2][2][4][2], const Unit& u, int wr, int wc, int fr, int fq) const {
        const float ALPHA = 1.4142135623730951f;
        const int grow0 = tok0 + u.pm * BM + wr * 64 + fr, col0 = u.pn * BM + wc * 32 + 4 * fq;
        const float* gp = gate + (size_t)((tok0 + u.pm * BM) >> 11) * 6144 + col0;
        f32x4 gv[2][2];
#pragma unroll
        for (int bj = 0; bj < 2; ++bj)
#pragma unroll
            for (int n = 0; n < 2; ++n) gv[bj][n] = *(const f32x4*)(gp + bj * HALF + n * 16);
#pragma unroll
        for (int ai = 0; ai < 2; ++ai)
#pragma unroll
            for (int m = 0; m < 4; ++m) { const size_t off = (size_t)(grow0 + ai * HALF + m * 16) * 1024 + col0;
#pragma unroll
                for (int bj = 0; bj < 2; ++bj)
#pragma unroll
                    for (int n = 0; n < 2; ++n) { const f32x4 xv = *(const f32x4*)(xin + off + bj * HALF + n * 16); *(f32x4*)(xout + off + bj * HALF + n * 16) = xv * ALPHA + gv[bj][n] * acc[ai][bj][m][n]; } }
    }
};
struct EpiUp {
    static constexpr bool PERM = true, AFTER_DRAIN = false;
    bf16_t* z; int ldc;
    __device__ __forceinline__ void operator()(const f32x4 (&acc)[2][2][4][2], const Unit& u, int wr, int wc, int fr, int fq) const {
        const int row0 = u.pm * BM + wr * 64 + fr, col0 = u.pn * BM + wc * 32 + 8 * fq;
#pragma unroll
        for (int ai = 0; ai < 2; ++ai)
#pragma unroll
            for (int m = 0; m < 4; ++m) { bf16_t* rowp = z + (size_t)(row0 + ai * HALF + m * 16) * ldc + col0;
#pragma unroll
                for (int bj = 0; bj < 2; ++bj) *(u32x4*)(rowp + bj * HALF) = pack8(acc[ai][bj][m][0], acc[ai][bj][m][1]); }
    }
};
struct BrOrder {
    StaticOrder base; int nM;
    __device__ void init(int M, int G_, int c_) { base.init(M, 1024, G_, c_); nM = M / BM; }
    __device__ bool next(int i, Unit& u) const { const int ti = i / 3, br = i - 3 * ti; Unit t; if (!base.next(ti, t)) return false; u.pm = br * nM + t.pm; u.pn = br * 4 + t.pn; return true; }
    __device__ __forceinline__ void a_ready(const Unit&) const {}
    __device__ __forceinline__ void done(const Unit&) const {}
};

template <class Epi, class Sched, bool ALIGN_EPI = false, bool SP2 = false>
__device__ __forceinline__ void gemm_phase(PG8_LAS unsigned char* lds, const Gemm g, const Sched& S, const Epi& E) {
    int tid_ = threadIdx.x; asm volatile("" : "+v"(tid_));
    const int tid = tid_, wid = __builtin_amdgcn_readfirstlane(tid >> 6), lane = tid & 63, wr = wid >> 2, wc = wid & 3, fr = lane & 15, fq = lane >> 4;
    const int K = g.K, nt = K / BK;
    unsigned voffA[2], voffB[2];
#pragma unroll
    for (int i = 0; i < 2; ++i) { int R, C; stage_rc(tid * 16 + i * 8192, R, C); const int Rb = Epi::PERM ? ((R & ~31) + perm32(R & 31)) : R;
        voffA[i] = (unsigned)(R * K + C) * 2u; voffB[i] = (unsigned)(Rb * K + C) * 2u; }
    const size_t kstep = (size_t)(BK * 2);
    const size_t hstep = (size_t)HALF * K * 2;
    const size_t tstep = 2 * hstep;
    const unsigned ldsw = (unsigned)wid * 1024u;
    const int aoff = lds_byte(wr * 64 + fr, fq * 8), boff = lds_byte(wc * 32 + fr, fq * 8);
#define PG8_SA(b, h) (((b) * 2 + (h)) * HTB)
#define PG8_SB(b, h) ((4 + (b) * 2 + (h)) * HTB)
#define PG8_STAGE(bufoff, gbase, voff) do { _Pragma("unroll") for (int _i = 0; _i < 2; ++_i) \
        __builtin_amdgcn_global_load_lds((const unsigned*)((const char*)(gbase) + (voff)[_i]), (PG8_LAS unsigned*)(lds + (bufoff) + ldsw + _i * 8192), 16, 0, 0); } while (0)
#define PG8_LDA(dst, b, h) do { _Pragma("unroll") for (int m = 0; m < 4; ++m) _Pragma("unroll") for (int k = 0; k < 2; ++k) dst[m][k] = *(const PG8_LAS bf16x8*)(lds + PG8_SA(b, h) + aoff + m * 2048 + k * 1024); } while (0)
#define PG8_LDB(dst, b, h) do { _Pragma("unroll") for (int n = 0; n < 2; ++n) _Pragma("unroll") for (int k = 0; k < 2; ++k) dst[n][k] = *(const PG8_LAS bf16x8*)(lds + PG8_SB(b, h) + boff + n * 2048 + k * 1024); } while (0)
#define PG8_MMA(ai, bj, At, Bt) do { __builtin_amdgcn_s_setprio(1); _Pragma("unroll") for (int m = 0; m < 4; ++m) _Pragma("unroll") for (int n = 0; n < 2; ++n) _Pragma("unroll") for (int k = 0; k < 2; ++k) \
        acc[ai][bj][m][n] = __builtin_amdgcn_mfma_f32_16x16x32_bf16(Bt[n][k], At[m][k], acc[ai][bj][m][n], 0, 0, 0); __builtin_amdgcn_s_setprio(0); } while (0)
#define PG8_WAIT_V(n) asm volatile("s_waitcnt vmcnt(" #n ")" ::: "memory")
#define PG8_WAIT_L(n) asm volatile("s_waitcnt lgkmcnt(" #n ")" ::: "memory")
#define PG8_BAR __builtin_amdgcn_s_barrier()
#define PG8_SCHED __builtin_amdgcn_sched_barrier(0)
    Unit cur, nxt; int ui = 0;
    if (!S.next(0, cur)) return;
    f32x4 acc[2][2][4][2];
#pragma unroll
    for (int a = 0; a < 2; ++a)
#pragma unroll
        for (int b = 0; b < 2; ++b)
#pragma unroll
            for (int m = 0; m < 4; ++m)
#pragma unroll
                for (int n = 0; n < 2; ++n) acc[a][b][m][n] = (f32x4){0.f, 0.f, 0.f, 0.f};
    bf16x8 At[4][2], B0[2][2], B1[2][2];
    const char* cA = (const char*)g.A + (size_t)cur.pm * tstep; const char* cB = (const char*)g.Bt + (size_t)cur.pn * tstep;
    S.a_ready(cur);
    if constexpr (SP2) {
        PG8_STAGE(PG8_SB(0, 0), cB, voffB); PG8_STAGE(PG8_SB(0, 1), cB + hstep, voffB); PG8_STAGE(PG8_SA(0, 0), cA, voffA); PG8_STAGE(PG8_SA(0, 1), cA + hstep, voffA);
        if (wr == 1) PG8_BAR;
        PG8_WAIT_V(2); PG8_BAR;
        PG8_STAGE(PG8_SB(1, 0), cB + kstep, voffB); PG8_STAGE(PG8_SA(1, 0), cA + kstep, voffA); PG8_STAGE(PG8_SB(1, 1), cB + hstep + kstep, voffB);
        PG8_WAIT_V(6); PG8_BAR;
    } else {
        PG8_STAGE(PG8_SB(0, 0), cB, voffB); PG8_STAGE(PG8_SA(0, 0), cA, voffA); PG8_STAGE(PG8_SB(0, 1), cB + hstep, voffB); PG8_STAGE(PG8_SA(0, 1), cA + hstep, voffA);
        if (wr == 1) PG8_BAR;
        PG8_WAIT_V(4); PG8_BAR;
        PG8_STAGE(PG8_SB(1, 0), cB + kstep, voffB); PG8_STAGE(PG8_SA(1, 0), cA + kstep, voffA); PG8_STAGE(PG8_SB(1, 1), cB + hstep + kstep, voffB);
        PG8_WAIT_V(6); PG8_BAR;
    }
    for (;;) {
        const bool has_next = S.next(ui + 1, nxt);
        const char* nA = has_next ? (const char*)g.A + (size_t)nxt.pm * tstep : cA; const char* nB = has_next ? (const char*)g.Bt + (size_t)nxt.pn * tstep : cB;
        for (int t = 0; t < nt; t += 2) {
            const bool last = (t == nt - 2);
            const char* a1 = cA + (size_t)(t + 1) * kstep;
            const char* a2 = last ? nA : cA + (size_t)(t + 2) * kstep; const char* b2 = last ? nB : cB + (size_t)(t + 2) * kstep;
            const char* a3 = a2 + kstep; const char* b3 = b2 + kstep;
            if (last && has_next) S.a_ready(nxt);
            if constexpr (SP2) {
            PG8_LDB(B0, 0, 0); PG8_LDB(B1, 0, 1); PG8_SCHED; PG8_LDA(At, 0, 0); PG8_STAGE(PG8_SA(1, 1), a1 + hstep, voffA);
            PG8_WAIT_V(8); PG8_WAIT_L(0); PG8_BAR; PG8_MMA(0, 0, At, B0); PG8_MMA(0, 1, At, B1); PG8_BAR; PG8_SCHED;
            PG8_LDA(At, 0, 1); PG8_STAGE(PG8_SB(0, 0), b2, voffB); PG8_STAGE(PG8_SB(0, 1), b2 + hstep, voffB); PG8_STAGE(PG8_SA(0, 0), a2, voffA);
            PG8_WAIT_V(8); PG8_WAIT_L(0); PG8_BAR; PG8_MMA(1, 0, At, B0); PG8_MMA(1, 1, At, B1); PG8_BAR; PG8_SCHED;
            PG8_LDB(B0, 1, 0); PG8_LDB(B1, 1, 1); PG8_SCHED; PG8_LDA(At, 1, 0); PG8_STAGE(PG8_SA(0, 1), a2 + hstep, voffA);
            PG8_WAIT_V(8); PG8_WAIT_L(0); PG8_BAR; PG8_MMA(0, 0, At, B0); PG8_MMA(0, 1, At, B1); PG8_BAR; PG8_SCHED;
            PG8_LDA(At, 1, 1); PG8_STAGE(PG8_SB(1, 0), b3, voffB); PG8_STAGE(PG8_SB(1, 1), b3 + hstep, voffB); PG8_STAGE(PG8_SA(1, 0), a3, voffA);
            PG8_WAIT_V(8); PG8_WAIT_L(0); PG8_BAR; PG8_MMA(1, 0, At, B0); PG8_MMA(1, 1, At, B1); PG8_BAR; PG8_SCHED;
            } else {
            PG8_LDB(B0, 0, 0); PG8_SCHED; PG8_LDA(At, 0, 0); PG8_STAGE(PG8_SA(1, 1), a1 + hstep, voffA);
            PG8_WAIT_L(8); PG8_BAR; PG8_WAIT_L(0); PG8_MMA(0, 0, At, B0); PG8_BAR; PG8_SCHED;
            PG8_LDB(B1, 0, 1); PG8_STAGE(PG8_SB(0, 0), b2, voffB);
            PG8_BAR; PG8_WAIT_L(0); PG8_MMA(0, 1, At, B1); PG8_BAR;
            PG8_LDA(At, 0, 1); PG8_STAGE(PG8_SA(0, 0), a2, voffA);
            PG8_BAR; PG8_WAIT_L(0); PG8_MMA(1, 0, At, B0); PG8_BAR; PG8_SCHED;
            PG8_STAGE(PG8_SB(0, 1), b2 + hstep, voffB);
            PG8_WAIT_V(6); PG8_BAR; PG8_MMA(1, 1, At, B1); PG8_BAR;
            PG8_LDB(B0, 1, 0); PG8_SCHED; PG8_LDA(At, 1, 0); PG8_STAGE(PG8_SA(0, 1), a2 + hstep, voffA);
            PG8_WAIT_L(8); PG8_BAR; PG8_WAIT_L(0); PG8_MMA(0, 0, At, B0); PG8_BAR; PG8_SCHED;
            PG8_LDB(B1, 1, 1); PG8_STAGE(PG8_SB(1, 0), b3, voffB);
            PG8_BAR; PG8_WAIT_L(0); PG8_MMA(0, 1, At, B1); PG8_BAR;
            PG8_LDA(At, 1, 1); PG8_STAGE(PG8_SA(1, 0), a3, voffA);
            PG8_BAR; PG8_WAIT_L(0); PG8_MMA(1, 0, At, B0); PG8_BAR; PG8_SCHED;
            PG8_STAGE(PG8_SB(1, 1), b3 + hstep, voffB);
            PG8_WAIT_V(6); PG8_BAR; PG8_MMA(1, 1, At, B1); PG8_BAR;
            }
        }
        if constexpr (ALIGN_EPI) { if (wr == 0) PG8_BAR; }
        if constexpr (!Epi::AFTER_DRAIN) { E(acc, cur, wr, wc, fr, fq); S.done(cur); }
        if (!has_next) break;
#pragma unroll
        for (int a = 0; a < 2; ++a)
#pragma unroll
            for (int b = 0; b < 2; ++b)
#pragma unroll
                for (int m = 0; m < 4; ++m)
#pragma unroll
                    for (int n = 0; n < 2; ++n) acc[a][b][m][n] = (f32x4){0.f, 0.f, 0.f, 0.f};
        cur = nxt; cA = nA; cB = nB; ++ui;
        if constexpr (ALIGN_EPI) { if (wr == 1) PG8_BAR; }
    }
    PG8_WAIT_V(0);
    if constexpr (!ALIGN_EPI) { if (wr == 0) PG8_BAR; }
    PG8_BAR;
    if constexpr (Epi::AFTER_DRAIN) { E.fused(acc, cur, wr, wc, fr, fq, lds, wid, lane); S.done(cur); }
#undef PG8_SA
#undef PG8_SB
#undef PG8_STAGE
#undef PG8_LDA
#undef PG8_LDB
#undef PG8_MMA
#undef PG8_WAIT_V
#undef PG8_WAIT_L
#undef PG8_BAR
#undef PG8_SCHED
}
}


#define LAS __attribute__((address_space(3)))
typedef unsigned short bf16_t;
typedef float f32x4 __attribute__((ext_vector_type(4)));
typedef float f32x16 __attribute__((ext_vector_type(16)));
typedef unsigned u32x4 __attribute__((ext_vector_type(4)));
typedef unsigned u32x2 __attribute__((ext_vector_type(2)));
typedef short bf16x8 __attribute__((ext_vector_type(8)));
typedef short s16x4 __attribute__((ext_vector_type(4)));
using pg8::pk2; using pg8::bf_lo; using pg8::bf_hi; using pg8::pack8;

constexpr int T_ALL = 65536, SEQ = 2048, NBATCH = 32, DM = 1024, NS = 2, TS = T_ALL / NS, BPS = NBATCH / NS;
constexpr int IN_W = 6592, N1 = 6656, NQ = 1536, DFF = 2816, NUP = 5632;
constexpr size_t MiB = 1u << 20;
constexpr size_t OFF_MOD = 0, OFF_COS = 2 * MiB, OFF_SIN = 10 * MiB, OFF_WSB = 18 * MiB, OFF_WL = 20 * MiB, WL_STRIDE = 40 * MiB;
constexpr size_t WO_W1 = 0, WO_WQ = 13 * MiB, WO_WBR = 14 * MiB, WO_WO = 20 * MiB, WO_WUP = 22 * MiB, WO_WDN = 33 * MiB;
constexpr size_t OFF_H = 128 * MiB, OFF_GATES = 192 * MiB, OFF_APOOL = 384 * MiB, OFF_RAW = 448 * MiB, OFF_PART = 384 * MiB, OFF_UV = 512 * MiB, OFF_QP = 512 * MiB,
                 OFF_BR = 640 * MiB, OFF_CQN = 832 * MiB, OFF_K192 = 848 * MiB, OFF_VT = 860 * MiB, OFF_Z = 192 * MiB, OFF_FF = 544 * MiB, WS_NEED = 868 * MiB;
constexpr int LDS_BYTES = 147456;
constexpr float LN_EPS = 1e-5f, RMS_EPS = 1e-6f;

struct Params {
    const float* x; const float* c; const int* pos; const float* w_ada; const float* b_ada; const float* w_in; const float* w_pool; const float* s_pool; const float* g_q; const float* w_uq;
    const float* g_kv; const float* w_ukv; const float* g_sg; const float* b_sg; const float* w_s; const float* b_s; const float* w_branch; const float* w_o; const float* ln_t_g; const float* ln_t_b;
    const float* w_up; const float* conv_w; const float* conv_b; const float* w_down; const float* ln_f_g; const float* ln_f_b;
    float* out; unsigned char* ws;
};

__device__ __forceinline__ int tid_opaque() { int t = threadIdx.x; asm volatile("" : "+v"(t)); return t; }
__device__ __forceinline__ float wave_sum(float v) {
    v += __shfl_xor(v, 32); v += __shfl_xor(v, 16); v += __shfl_xor(v, 8); v += __shfl_xor(v, 4); v += __shfl_xor(v, 2); v += __shfl_xor(v, 1); return v;
}

__device__ __forceinline__ void xpose_tile(const float* src, int ld, int k0, int c0, bf16_t* dst, int ldd, int n0, LAS float* tile) {
    const int tid = tid_opaque(), r = tid >> 3, cc = (tid & 7) * 8;
    f32x4 a = {0.f, 0.f, 0.f, 0.f}, b = {0.f, 0.f, 0.f, 0.f};
    if (c0 >= 0) { const float* s = src + (size_t)(k0 + r) * ld + c0 + cc; a = *(const f32x4*)s; b = *(const f32x4*)(s + 4); }
#pragma unroll
    for (int e = 0; e < 4; ++e) { tile[r * 65 + cc + e] = a[e]; tile[r * 65 + cc + 4 + e] = b[e]; }
    __syncthreads();
    float v[8];
#pragma unroll
    for (int e = 0; e < 8; ++e) v[e] = tile[(cc + e) * 65 + r];
    u32x4 w; w.x = pk2(v[0], v[1]); w.y = pk2(v[2], v[3]); w.z = pk2(v[4], v[5]); w.w = pk2(v[6], v[7]);
    *(u32x4*)(dst + (size_t)(n0 + r) * ldd + k0 + cc) = w;
    __syncthreads();
}

typedef const Params __attribute__((address_space(4)))* KPtr;
__device__ __forceinline__ KPtr kparams() { KPtr k = (KPtr)__builtin_amdgcn_kernarg_segment_ptr(); asm volatile("" : "+s"(k)); return k; }
__device__ __forceinline__ void prep_phase(KPtr pp, LAS unsigned char* lds, int G, int bid) {
    const int tid = tid_opaque(), lane = tid & 63, wid = tid >> 6;
    const int gtid = bid * 512 + tid, gsz = G * 512;
    unsigned char* ws = pp->ws;
    { float* COS = (float*)(ws + OFF_COS); float* SIN = (float*)(ws + OFF_SIN);
      for (int i = gtid; i < T_ALL * 32; i += gsz) {
          const int t = i >> 5, f = i & 31;
          double fr = 1.0; for (int k = 0; k < f; ++k) fr *= 0.7498942093324559;
          const double ang = (double)pp->pos[t] * fr;
          const double kq = __builtin_rint(ang * 0.15915494309189535);
          double r = __builtin_fma(-kq, 6.283185307179586, ang); r = __builtin_fma(-kq, 2.4492935982947064e-16, r);
          const double r2 = r * r; double sn = 1.0, cs = 1.0;
          for (int k = 15; k >= 1; --k) { sn = 1.0 - sn * r2 / (double)((2 * k) * (2 * k + 1)); cs = 1.0 - cs * r2 / (double)((2 * k - 1) * (2 * k)); }
          COS[i] = (float)cs; SIN[i] = (float)(sn * r);
      } }
    { bf16_t* WSB = (bf16_t*)(ws + OFF_WSB);
      for (int i = gtid; i < 2 * 8 * 128 * 128 / 2; i += gsz) { const int e = i * 2, tt = (e >> 7) & 127, ss = e & 127;
          const float a = ss <= tt ? pp->w_s[e] : 0.f, b = (ss + 1) <= tt ? pp->w_s[e + 1] : 0.f; ((unsigned*)WSB)[i] = pk2(a, b); } }
    { LAS float* tile = (LAS float*)lds;
      for (int ti = bid; ti < 2 * 4288; ti += G) {
          const int l = ti / 4288; int r = ti - l * 4288; unsigned char* wl = ws + OFF_WL + (size_t)l * WL_STRIDE;
          if (r < 1664) { const int nb = r >> 4, kb = r & 15, n0 = nb * 64; int c0;
              if (n0 < 4096) c0 = n0; else if (n0 < 6144) c0 = 4544 + (n0 - 4096); else if (n0 < 6400) c0 = 4096 + (n0 - 6144); else if (n0 < 6528) c0 = 4352 + (n0 - 6400); else if (n0 < 6592) c0 = 4480 + (n0 - 6528); else c0 = -1;
              xpose_tile(pp->w_in + (size_t)l * 1024 * IN_W, IN_W, kb * 64, c0, (bf16_t*)(wl + WO_W1), 1024, n0, tile); }
          else if (r < 1920) { r -= 1664; const int nb = r >> 4, kb = r & 15;
              xpose_tile(pp->w_branch + ((size_t)l * 3 + 2) * 1048576, 1024, kb * 64, nb * 64, (bf16_t*)(wl + WO_WBR) + 2 * 1048576, 1024, nb * 64, tile); }
          else if (r < 2176) { r -= 1920; const int nb = r >> 4, kb = r & 15;
              xpose_tile(pp->w_o + (size_t)l * 1048576, 1024, kb * 64, nb * 64, (bf16_t*)(wl + WO_WO), 1024, nb * 64, tile); }
          else if (r < 3584) { r -= 2176; const int nb = r >> 4, kb = r & 15, n0 = nb * 64, uu = n0 >> 8, cc0 = n0 & 255, c0 = (cc0 >> 7) * DFF + 128 * uu + (cc0 & 127);
              xpose_tile(pp->w_up + (size_t)l * 1024 * NUP, NUP, kb * 64, c0, (bf16_t*)(wl + WO_WUP), 1024, n0, tile); }
          else { r -= 3584; const int nb = r / 44, kb = r - nb * 44;
              xpose_tile(pp->w_down + (size_t)l * DFF * 1024, 1024, kb * 64, nb * 64, (bf16_t*)(wl + WO_WDN), DFF, nb * 64, tile); }
      } }
    for (int i = gtid; i < 2 * 1024 * 256; i += gsz) { const int l = i >> 18, n = (i >> 8) & 1023, r = i & 255, h = n >> 7, j = n & 127;
        const float* a = pp->w_uq + ((size_t)(l * 256 + r) * 8 + h) * 192; const float* b = pp->w_ukv + ((size_t)(l * 128 + j) * 8 + h) * 256; float s = 0.f;
        for (int d = 0; d < 128; d += 4) { const f32x4 av = *(const f32x4*)(a + d), bv = *(const f32x4*)(b + d); s += av[0] * bv[0] + av[1] * bv[1] + av[2] * bv[2] + av[3] * bv[3]; }
        ((bf16_t*)(ws + OFF_WL + (size_t)l * WL_STRIDE + WO_WQ))[(size_t)n * 256 + r] = (bf16_t)(pk2(s, 0.f) & 0xffffu); }
    for (int i = gtid; i < 2 * 512 * 256; i += gsz) { const int l = i >> 17, n = (i >> 8) & 511, r = i & 255, u2 = n >> 8, cc = n & 255, bj = cc >> 7, h = 4 * u2 + ((cc >> 5) & 3), dd = 128 + (cc & 31) + 32 * bj;
        const float v = pp->w_uq[((size_t)(l * 256 + r) * 8 + h) * 192 + dd];
        ((bf16_t*)(ws + OFF_WL + (size_t)l * WL_STRIDE + WO_WQ))[(size_t)(1024 + n) * 256 + r] = (bf16_t)(pk2(v, 0.f) & 0xffffu); }
    for (int i = gtid; i < 2 * 2 * 1048576; i += gsz) { const int l = i >> 21, which = (i >> 20) & 1, kk = (i >> 10) & 1023, n = i & 1023; float s = 0.f;
        if (which == 1) { const int h = kk >> 7, j = kk & 127; const float* a = pp->w_ukv + ((size_t)(l * 128 + j) * 8 + h) * 256 + 128; const float* b = pp->w_branch + ((size_t)(l * 3 + 1) * 1024 + h * 128) * 1024 + n;
            for (int d = 0; d < 128; ++d) s += a[d] * b[(size_t)d * 1024]; }
        else { const int g = kk >> 8, c = kk & 255; const float* a = pp->w_pool + ((size_t)(l * 4 + g) * 256 + c) * 256; const float* sp = pp->s_pool + l * 1024 + g * 256; const float* b = pp->w_branch + ((size_t)(l * 3 + 0) * 1024 + g * 256) * 1024 + n;
            for (int d = 0; d < 256; ++d) s += a[d] * sp[d] * b[(size_t)d * 1024]; }
        ((bf16_t*)(ws + OFF_WL + (size_t)l * WL_STRIDE + WO_WBR))[((size_t)which * 1024 + n) * 1024 + kk] = (bf16_t)(pk2(s, 0.f) & 0xffffu); }
    { LAS float* tab = (LAS float*)lds; LAS float* part = tab + 16384; float* MOD = (float*)(ws + OFF_MOD);
      __syncthreads();
      for (int it = bid; it < 384; it += G) { const int l = it / 192, rem = it - l * 192, nc = rem >> 1, bh = rem & 1;
          for (int i = tid; i < 16384; i += 512) { const int k = i >> 4, bb = i & 15; const float cv = pp->c[(bh * 16 + bb) * 1024 + k]; tab[i] = cv / (1.0f + __expf(-cv)); }
          __syncthreads();
          float acc[16];
#pragma unroll
          for (int b = 0; b < 16; ++b) acc[b] = 0.f;
          const float* wp = pp->w_ada + ((size_t)l * 1024 + wid * 128) * 6144 + nc * 64 + lane;
          for (int k = 0; k < 128; ++k) { const float wv = wp[(size_t)k * 6144]; const LAS f32x4* tp = (const LAS f32x4*)(tab + (wid * 128 + k) * 16);
#pragma unroll
              for (int q = 0; q < 4; ++q) { const f32x4 tv = tp[q]; acc[4 * q] += tv[0] * wv; acc[4 * q + 1] += tv[1] * wv; acc[4 * q + 2] += tv[2] * wv; acc[4 * q + 3] += tv[3] * wv; } }
#pragma unroll
          for (int b = 0; b < 16; ++b) part[(wid * 16 + b) * 64 + lane] = acc[b];
          __syncthreads();
          for (int o = tid; o < 1024; o += 512) { const int bb = o >> 6, nn = o & 63; float s = pp->b_ada[l * 6144 + nc * 64 + nn];
#pragma unroll
              for (int w = 0; w < 8; ++w) s += part[(w * 16 + bb) * 64 + nn];
              MOD[(size_t)(l * 32 + bh * 16 + bb) * 6144 + nc * 64 + nn] = s; }
          __syncthreads();
      } }
}

template <int MODE>
__device__ __forceinline__ void ln_pass(const float* xin, float* xout, bf16_t* hout, int tok0, const float* lng, const float* lnb, const float* modsh, const float* modsc, int G, int bid) {
    const int tid = tid_opaque(), lane = tid & 63, wid = tid >> 6;
    for (int r = bid * 8 + wid; r < TS; r += G * 8) {
        const size_t grow = (size_t)tok0 + r; const int b = (int)(grow >> 11);
        const float* xp = xin + grow * 1024 + lane * 4;
        f32x4 v[4];
#pragma unroll
        for (int q = 0; q < 4; ++q) v[q] = *(const f32x4*)(xp + q * 256);
        float s = 0.f;
#pragma unroll
        for (int q = 0; q < 4; ++q) s += (v[q][0] + v[q][1]) + (v[q][2] + v[q][3]);
        float mean = wave_sum(s) * (1.0f / 1024.0f); float qq = 0.f;
#pragma unroll
        for (int q = 0; q < 4; ++q) { const f32x4 d = v[q] - mean; qq += (d[0] * d[0] + d[1] * d[1]) + (d[2] * d[2] + d[3] * d[3]); }
        float rstd = 1.0f / sqrtf(wave_sum(qq) * (1.0f / 1024.0f) + LN_EPS);
        if (MODE == 1) {
            float* op = xout + grow * 1024 + lane * 4;
#pragma unroll
            for (int q = 0; q < 4; ++q) { const f32x4 g = *(const f32x4*)(lng + lane * 4 + q * 256), bb = *(const f32x4*)(lnb + lane * 4 + q * 256); v[q] = (v[q] - mean) * rstd * g + bb; *(f32x4*)(op + q * 256) = v[q]; }
            if (!hout) continue;
            s = 0.f;
#pragma unroll
            for (int q = 0; q < 4; ++q) s += (v[q][0] + v[q][1]) + (v[q][2] + v[q][3]);
            mean = wave_sum(s) * (1.0f / 1024.0f); qq = 0.f;
#pragma unroll
            for (int q = 0; q < 4; ++q) { const f32x4 d = v[q] - mean; qq += (d[0] * d[0] + d[1] * d[1]) + (d[2] * d[2] + d[3] * d[3]); }
            rstd = 1.0f / sqrtf(wave_sum(qq) * (1.0f / 1024.0f) + LN_EPS);
        }
        bf16_t* hp = hout + (size_t)r * 1024 + lane * 4;
#pragma unroll
        for (int q = 0; q < 4; ++q) { const f32x4 sc = *(const f32x4*)(modsc + (size_t)b * 6144 + lane * 4 + q * 256), sh = *(const f32x4*)(modsh + (size_t)b * 6144 + lane * 4 + q * 256);
            const f32x4 y = (v[q] - mean) * rstd * (sc + 1.0f) + sh; u32x2 w; w.x = pk2(y[0], y[1]); w.y = pk2(y[2], y[3]); *(u32x2*)(hp + q * 256) = w; }
    }
}

__device__ __forceinline__ void unpack8(const u32x4 w, float (&f)[8]) { f[0] = bf_lo(w.x); f[1] = bf_hi(w.x); f[2] = bf_lo(w.y); f[3] = bf_hi(w.y); f[4] = bf_lo(w.z); f[5] = bf_hi(w.z); f[6] = bf_lo(w.w); f[7] = bf_hi(w.w); }

__device__ __forceinline__ void pool_pass(const bf16_t* apool, bf16_t* pooled, int G, int bid) {
    const int gtid = bid * 512 + tid_opaque(), gsz = G * 512;
    for (int id = gtid; id < TS * 128; id += gsz) {
        const int tok = id >> 7, ch = id & 127, s = tok & (SEQ - 1), w = 2 << (ch >> 5), cnt = (s + 1) < w ? (s + 1) : w;
        const bf16_t* ap = apool + (size_t)tok * 1024 + ch * 8;
        float self[8], sum[8]; unpack8(*(const u32x4*)ap, self);
#pragma unroll
        for (int e = 0; e < 8; ++e) sum[e] = self[e];
        for (int k = 1; k < cnt; ++k) { float t[8]; unpack8(*(const u32x4*)(ap - (size_t)k * 1024), t);
#pragma unroll
            for (int e = 0; e < 8; ++e) sum[e] += t[e]; }
        const float inv = 1.0f / (float)cnt; float o[8];
#pragma unroll
        for (int e = 0; e < 8; ++e) o[e] = sum[e] * inv - self[e];
        u32x4 wv; wv.x = pk2(o[0], o[1]); wv.y = pk2(o[2], o[3]); wv.z = pk2(o[4], o[5]); wv.w = pk2(o[6], o[7]);
        *(u32x4*)(pooled + (size_t)tok * 1024 + ch * 8) = wv;
    }
}

__device__ __forceinline__ void norm_pass(const float* raw, bf16_t* cqn, bf16_t* k192, bf16_t* vt, const float* gq, const float* gkv, const float* cosT, const float* sinT, int tok0, LAS unsigned char* lds, int G, int bid) {
    const int tid = tid_opaque(), lane = tid & 63, wid = tid >> 6;
    LAS bf16_t* tl = (LAS bf16_t*)lds;
    const f32x4 gqv = *(const f32x4*)(gq + lane * 4); const float gk0 = gkv[2 * lane], gk1 = gkv[2 * lane + 1];
    for (int it = bid; it < TS / 64; it += G) {
        for (int j = wid * 8; j < wid * 8 + 8; ++j) { const int tok = it * 64 + j; const float* rp = raw + (size_t)tok * 512;
            const f32x4 q = *(const f32x4*)(rp + lane * 4); const float k0 = rp[256 + 2 * lane], k1 = rp[256 + 2 * lane + 1];
            const float rq = 1.0f / sqrtf(wave_sum((q[0] * q[0] + q[1] * q[1]) + (q[2] * q[2] + q[3] * q[3])) * (1.0f / 256.0f) + RMS_EPS);
            const float rk = 1.0f / sqrtf(wave_sum(k0 * k0 + k1 * k1) * (1.0f / 128.0f) + RMS_EPS);
            u32x2 w; w.x = pk2(q[0] * rq * gqv[0], q[1] * rq * gqv[1]); w.y = pk2(q[2] * rq * gqv[2], q[3] * rq * gqv[3]); *(u32x2*)(cqn + (size_t)tok * 256 + lane * 4) = w;
            const unsigned kw = pk2(k0 * rk * gk0, k1 * rk * gk1);
            *(unsigned*)(k192 + (size_t)tok * 192 + 2 * lane) = kw; *(LAS unsigned*)(tl + j * 130 + 2 * lane) = kw;
            if (lane < 32) { const float x1 = rp[384 + lane], x2 = rp[416 + lane]; const size_t tr = (size_t)(tok0 + tok) * 32 + lane; const float cs = cosT[tr], sn = sinT[tr];
                k192[(size_t)tok * 192 + 128 + lane] = (bf16_t)(pk2(x1 * cs - x2 * sn, 0.f) & 0xffffu); k192[(size_t)tok * 192 + 160 + lane] = (bf16_t)(pk2(x2 * cs + x1 * sn, 0.f) & 0xffffu); } }
        __syncthreads();
        { const int d = tid >> 2, part = tid & 3, tokb = it * 64, b = tokb >> 11, s0 = (tokb & (SEQ - 1)) + part * 16; unsigned w[8];
#pragma unroll
          for (int e = 0; e < 8; ++e) { const unsigned lo = tl[(part * 16 + 2 * e) * 130 + d], hi = tl[(part * 16 + 2 * e + 1) * 130 + d]; w[e] = lo | (hi << 16); }
          bf16_t* vp = vt + ((size_t)b * 128 + d) * SEQ + s0;
          *(u32x4*)vp = (u32x4){w[0], w[1], w[2], w[3]}; *(u32x4*)(vp + 8) = (u32x4){w[4], w[5], w[6], w[7]}; }
        __syncthreads();
    }
}

__device__ __forceinline__ void sgu_pass(const bf16_t* uv, bf16_t* outp, const bf16_t* wsb, const float* bs, const float* gsg, const float* bsg, LAS unsigned char* lds, int G, int bid) {
    const int tid = tid_opaque(), lane = tid & 63, wid = tid >> 6, n = lane & 31, hh = lane >> 5;
    LAS unsigned char* vnt = lds;
    LAS float* stats = (LAS float*)(lds + 128 * 272);
    for (int it = bid; it < TS / 128; it += G) {
        const int tokb = it * 128;
        for (int j = wid * 16; j < wid * 16 + 16; ++j) { const bf16_t* vp = uv + (size_t)(tokb + j) * 2048 + 1024 + lane * 8;
            float a[8], b[8]; unpack8(*(const u32x4*)vp, a); unpack8(*(const u32x4*)(vp + 512), b); float s = 0.f;
#pragma unroll
            for (int e = 0; e < 8; ++e) s += a[e] + b[e];
            const float mean = wave_sum(s) * (1.0f / 1024.0f); float qq = 0.f;
#pragma unroll
            for (int e = 0; e < 8; ++e) { const float da = a[e] - mean, db = b[e] - mean; qq += da * da + db * db; }
            const float rstd = 1.0f / sqrtf(wave_sum(qq) * (1.0f / 1024.0f) + LN_EPS);
            if (lane == 0) { stats[2 * j] = mean; stats[2 * j + 1] = rstd; } }
        __syncthreads();
        for (int g = 0; g < 8; ++g) {
            { const int ch = tid & 15, half = (tid >> 4) & 1, sb = tid >> 5, s0 = sb * 8 + half * 4; float x[4][8];
#pragma unroll
              for (int q = 0; q < 4; ++q) { unpack8(*(const u32x4*)(uv + (size_t)(tokb + s0 + q) * 2048 + 1024 + g * 128 + ch * 8), x[q]); const float mu = stats[2 * (s0 + q)], rs = stats[2 * (s0 + q) + 1];
#pragma unroll
                  for (int e = 0; e < 8; ++e) x[q][e] = (x[q][e] - mu) * rs; }
              const f32x4 g0 = *(const f32x4*)(gsg + g * 128 + ch * 8), g1 = *(const f32x4*)(gsg + g * 128 + ch * 8 + 4), b0 = *(const f32x4*)(bsg + g * 128 + ch * 8), b1 = *(const f32x4*)(bsg + g * 128 + ch * 8 + 4);
#pragma unroll
              for (int e = 0; e < 8; ++e) { const float ge = e < 4 ? g0[e & 3] : g1[e & 3], be = e < 4 ? b0[e & 3] : b1[e & 3]; u32x2 w; w.x = pk2(x[0][e] * ge + be, x[1][e] * ge + be); w.y = pk2(x[2][e] * ge + be, x[3][e] * ge + be);
                  *(LAS u32x2*)(vnt + (ch * 8 + e) * 272 + ((sb ^ ch) * 16) + half * 8) = w; } }
            __syncthreads();
            { const int tb = wid & 3, cb0 = (wid >> 2) * 2, t = tb * 32 + n; f32x16 acc0, acc1;
#pragma unroll
              for (int i = 0; i < 16; ++i) { acc0[i] = 0.f; acc1[i] = 0.f; }
              const bf16_t* wp = wsb + ((size_t)g * 128 + t) * 128 + 8 * hh; const int c0 = cb0 * 32 + n, c1 = c0 + 32;
              for (int ks = 0; ks < 2 * (tb + 1); ++ks) { const bf16x8 bf = *(const bf16x8*)(wp + 16 * ks);
                  const bf16x8 a0 = *(const LAS bf16x8*)(vnt + c0 * 272 + (((2 * ks + hh) ^ (c0 >> 3)) * 16)), a1 = *(const LAS bf16x8*)(vnt + c1 * 272 + (((2 * ks + hh) ^ (c1 >> 3)) * 16));
                  acc0 = __builtin_amdgcn_mfma_f32_32x32x16_bf16(a0, bf, acc0, 0, 0, 0); acc1 = __builtin_amdgcn_mfma_f32_32x32x16_bf16(a1, bf, acc1, 0, 0, 0); }
              const float bsv = bs[t * 8 + g]; const size_t tok = (size_t)(tokb + t);
#pragma unroll
              for (int cbi = 0; cbi < 2; ++cbi)
#pragma unroll
                  for (int gq = 0; gq < 4; ++gq) { const int cc = g * 128 + (cb0 + cbi) * 32 + 8 * gq + 4 * hh; const u32x2 uw = *(const u32x2*)(uv + tok * 2048 + cc);
                      const float z0 = (cbi ? acc1[4 * gq] : acc0[4 * gq]) + bsv, z1 = (cbi ? acc1[4 * gq + 1] : acc0[4 * gq + 1]) + bsv, z2 = (cbi ? acc1[4 * gq + 2] : acc0[4 * gq + 2]) + bsv, z3 = (cbi ? acc1[4 * gq + 3] : acc0[4 * gq + 3]) + bsv;
                      u32x2 w; w.x = pk2(bf_lo(uw.x) * z0, bf_hi(uw.x) * z1); w.y = pk2(bf_lo(uw.y) * z2, bf_hi(uw.y) * z3); *(u32x2*)(outp + tok * 1024 + cc) = w; } }
            __syncthreads();
        }
    }
}

constexpr int AT_KSTR = 400, AT_VSTR = 136, AT_KBYTES = 64 * AT_KSTR, AT_VBYTES = 128 * AT_VSTR, AT_STAGE = AT_KBYTES + AT_VBYTES;
__device__ __forceinline__ void attn_phase(LAS unsigned char* lds, const bf16_t* QP, const bf16_t* K192, const bf16_t* VT, bf16_t* CTX, int G, int bid) {
    const int tid = tid_opaque(), lane = tid & 63, wid = __builtin_amdgcn_readfirstlane(tid >> 6), n = lane & 31, hh = lane >> 5;
    constexpr int NITEMS = BPS * 32 * 2;
    for (int rnd = 0; rnd * G < NITEMS; ++rnd) {
        const int j = rnd * G + ((rnd & 1) ? (G - 1 - bid) : bid);
        if (j >= NITEMS) continue;
        const int c = 31 - (j >> 5), sub = j & 31, b = sub >> 1, hq = sub & 1;
        const int h = hq * 4 + (wid & 3), qs = wid >> 2;
        const size_t tq = (size_t)b * SEQ + c * 64 + qs * 32 + n;
        bf16x8 qf[12];
        { const bf16_t* qptr = QP + tq * NQ + h * 192 + 8 * hh;
#pragma unroll
          for (int ks = 0; ks < 12; ++ks) qf[ks] = *(const bf16x8*)(qptr + 16 * ks); }
        f32x16 o[4];
#pragma unroll
        for (int db = 0; db < 4; ++db)
#pragma unroll
            for (int i = 0; i < 16; ++i) o[db][i] = 0.f;
        float m_run = -__builtin_inff(), l_run = 0.f;
        const bf16_t* kbase = K192 + (size_t)b * SEQ * 192; const bf16_t* vbase = VT + (size_t)b * 128 * SEQ;
        u32x4 kr[3], vr[2];
#define AT_LOAD(kt) do { _Pragma("unroll") for (int i = 0; i < 3; ++i) { const int id = tid + 512 * i, row = id / 24, cc = id - row * 24; kr[i] = *(const u32x4*)(kbase + (size_t)((kt) * 64 + row) * 192 + cc * 8); } \
        _Pragma("unroll") for (int i = 0; i < 2; ++i) { const int id = tid + 512 * i, d = id >> 3, cc = id & 7; vr[i] = *(const u32x4*)(vbase + (size_t)d * SEQ + (kt) * 64 + cc * 8); } } while (0)
#define AT_STORE(buf) do { LAS unsigned char* sb_ = lds + (buf) * AT_STAGE; _Pragma("unroll") for (int i = 0; i < 3; ++i) { const int id = tid + 512 * i, row = id / 24, cc = id - row * 24; *(LAS u32x4*)(sb_ + row * AT_KSTR + cc * 16) = kr[i]; } \
        _Pragma("unroll") for (int i = 0; i < 2; ++i) { const int id = tid + 512 * i, d = id >> 3, cc = id & 7; LAS unsigned char* vp_ = sb_ + AT_KBYTES + d * AT_VSTR + cc * 16; *(LAS u32x2*)vp_ = (u32x2){vr[i].x, vr[i].y}; *(LAS u32x2*)(vp_ + 8) = (u32x2){vr[i].z, vr[i].w}; } } while (0)
        AT_LOAD(0); AT_STORE(0);
        __syncthreads();
        for (int kt = 0; kt <= c; ++kt) {
            if (kt < c) AT_LOAD(kt + 1);
            const LAS unsigned char* Ks = lds + (kt & 1) * AT_STAGE; const LAS unsigned char* Vs = Ks + AT_KBYTES;
            f32x16 s0, s1;
#pragma unroll
            for (int i = 0; i < 16; ++i) { s0[i] = 0.f; s1[i] = 0.f; }
            { const LAS unsigned char* ka = Ks + n * AT_KSTR + hh * 16;
#pragma unroll
              for (int ks = 0; ks < 12; ++ks) { const bf16x8 a0 = *(const LAS bf16x8*)(ka + ks * 32), a1 = *(const LAS bf16x8*)(ka + 32 * AT_KSTR + ks * 32);
                  s0 = __builtin_amdgcn_mfma_f32_32x32x16_bf16(a0, qf[ks], s0, 0, 0, 0); s1 = __builtin_amdgcn_mfma_f32_32x32x16_bf16(a1, qf[ks], s1, 0, 0, 0); } }
            float mx = s0[0];
#pragma unroll
            for (int i = 1; i < 16; ++i) mx = fmaxf(mx, s0[i]);
#pragma unroll
            for (int i = 0; i < 16; ++i) mx = fmaxf(mx, s1[i]);
            mx = fmaxf(mx, __shfl_xor(mx, 32));
            const float m_new = fmaxf(m_run, mx), alpha = __builtin_amdgcn_exp2f(m_run - m_new); m_run = m_new;
            float rs = 0.f;
#pragma unroll
            for (int i = 0; i < 16; ++i) { s0[i] = __builtin_amdgcn_exp2f(s0[i] - m_new); s1[i] = __builtin_amdgcn_exp2f(s1[i] - m_new); rs += s0[i] + s1[i]; }
            rs += __shfl_xor(rs, 32); l_run = l_run * alpha + rs;
#pragma unroll
            for (int db = 0; db < 4; ++db) o[db] *= alpha;
#pragma unroll
            for (int mb = 0; mb < 2; ++mb)
#pragma unroll
                for (int jj = 0; jj < 2; ++jj) {
                    u32x4 pw;
                    if (mb == 0) { pw.x = pk2(s0[8 * jj], s0[8 * jj + 1]); pw.y = pk2(s0[8 * jj + 2], s0[8 * jj + 3]); pw.z = pk2(s0[8 * jj + 4], s0[8 * jj + 5]); pw.w = pk2(s0[8 * jj + 6], s0[8 * jj + 7]); }
                    else { pw.x = pk2(s1[8 * jj], s1[8 * jj + 1]); pw.y = pk2(s1[8 * jj + 2], s1[8 * jj + 3]); pw.z = pk2(s1[8 * jj + 4], s1[8 * jj + 5]); pw.w = pk2(s1[8 * jj + 6], s1[8 * jj + 7]); }
                    const bf16x8 pf = __builtin_bit_cast(bf16x8, pw);
                    const LAS unsigned char* va = Vs + n * AT_VSTR + (mb * 32 + 16 * jj + 4 * hh) * 2;
#pragma unroll
                    for (int db = 0; db < 4; ++db) { const s16x4 lo = *(const LAS s16x4*)(va + db * 32 * AT_VSTR), hi = *(const LAS s16x4*)(va + db * 32 * AT_VSTR + 16);
                        const bf16x8 vf = __builtin_shufflevector(lo, hi, 0, 1, 2, 3, 4, 5, 6, 7);
                        o[db] = __builtin_amdgcn_mfma_f32_32x32x16_bf16(vf, pf, o[db], 0, 0, 0); }
                }
            if (kt < c) AT_STORE((kt + 1) & 1);
            __syncthreads();
        }
#undef AT_LOAD
#undef AT_STORE
        { const float inv = 1.0f / l_run; bf16_t* optr = CTX + tq * 1024 + h * 128 + 4 * hh;
#pragma unroll
          for (int db = 0; db < 4; ++db)
#pragma unroll
              for (int gq = 0; gq < 4; ++gq) { u32x2 w; w.x = pk2(o[db][4 * gq] * inv, o[db][4 * gq + 1] * inv); w.y = pk2(o[db][4 * gq + 2] * inv, o[db][4 * gq + 3] * inv); *(u32x2*)(optr + db * 32 + 8 * gq) = w; } }
    }
}

__device__ __forceinline__ void conv_pass(const bf16_t* z, bf16_t* ff, const float* cw, const float* cb, int G, int bid) {
    const int gtid = bid * 512 + tid_opaque(), gsz = G * 512;
    constexpr int RUN = 32, NTASK = (TS / RUN) * 352;
    for (int id = gtid; id < NTASK; id += gsz) {
        const int run = id / 352, ch = id - run * 352, uu = ch >> 4, j0 = (ch & 15) * 8, colv = 128 * uu + j0, colg = DFF + colv, tok0 = run * RUN, s0 = tok0 & (SEQ - 1);
        float wv[3][8], wg[3][8], bv[8], bg[8];
#pragma unroll
        for (int k = 0; k < 3; ++k) { const f32x4 a = *(const f32x4*)(cw + k * NUP + colv), b = *(const f32x4*)(cw + k * NUP + colv + 4), c = *(const f32x4*)(cw + k * NUP + colg), d = *(const f32x4*)(cw + k * NUP + colg + 4);
#pragma unroll
            for (int e = 0; e < 4; ++e) { wv[k][e] = a[e]; wv[k][4 + e] = b[e]; wg[k][e] = c[e]; wg[k][4 + e] = d[e]; } }
        { const f32x4 a = *(const f32x4*)(cb + colv), b = *(const f32x4*)(cb + colv + 4), c = *(const f32x4*)(cb + colg), d = *(const f32x4*)(cb + colg + 4);
#pragma unroll
          for (int e = 0; e < 4; ++e) { bv[e] = a[e]; bv[4 + e] = b[e]; bg[e] = c[e]; bg[4 + e] = d[e]; } }
        const bf16_t* zp = z + (size_t)tok0 * NUP + 256 * uu + j0;
        float v2[8], v1[8], g2[8], g1[8];
        if (s0 > 0) { unpack8(*(const u32x4*)(zp - 2 * NUP), v2); unpack8(*(const u32x4*)(zp - NUP), v1); unpack8(*(const u32x4*)(zp - 2 * NUP + 128), g2); unpack8(*(const u32x4*)(zp - NUP + 128), g1); }
        else {
#pragma unroll
            for (int e = 0; e < 8; ++e) { v2[e] = 0.f; v1[e] = 0.f; g2[e] = 0.f; g1[e] = 0.f; } }
        for (int r = 0; r < RUN; ++r) { float v0[8], g0[8], o[8]; unpack8(*(const u32x4*)(zp + (size_t)r * NUP), v0); unpack8(*(const u32x4*)(zp + (size_t)r * NUP + 128), g0);
#pragma unroll
            for (int e = 0; e < 8; ++e) { const float vc = bv[e] + wv[0][e] * v2[e] + wv[1][e] * v1[e] + wv[2][e] * v0[e], gc = bg[e] + wg[0][e] * g2[e] + wg[1][e] * g1[e] + wg[2][e] * g0[e];
                o[e] = gc * pg8::sigm(gc) * vc; v2[e] = v1[e]; v1[e] = v0[e]; g2[e] = g1[e]; g1[e] = g0[e]; }
            u32x4 w; w.x = pk2(o[0], o[1]); w.y = pk2(o[2], o[3]); w.z = pk2(o[4], o[5]); w.w = pk2(o[6], o[7]);
            *(u32x4*)(ff + (size_t)(tok0 + r) * DFF + colv) = w; }
    }
}

__global__ void __launch_bounds__(512, 2) mega_fwd(Params p_unused) {
    extern __shared__ __attribute__((aligned(16))) unsigned char lds_raw[];
    LAS unsigned char* lds = (LAS unsigned char*)lds_raw;
    cg::grid_group grid = cg::this_grid();
    (void)p_unused;
#define PH_BEGIN KPtr p = kparams(); int G = (int)gridDim.x, bid = (int)blockIdx.x; asm volatile("" : "+s"(G), "+s"(bid)); unsigned char* ws = p->ws; (void)ws;
    { PH_BEGIN prep_phase(p, lds, G, bid); }
    grid.sync();
    for (int sl = 0; sl < NS; ++sl) {
        const int tok0 = sl * TS;
        { PH_BEGIN const float* MOD = (const float*)(ws + OFF_MOD);
          ln_pass<0>(p->x, nullptr, (bf16_t*)(ws + OFF_H), tok0, nullptr, nullptr, MOD + 0, MOD + 1024, G, bid); }
        grid.sync();
        for (int l = 0; l < 2; ++l) {
            { PH_BEGIN const unsigned char* wl = ws + OFF_WL + (size_t)l * WL_STRIDE;
              pg8::Gemm g{(const bf16_t*)(ws + OFF_H), (const bf16_t*)(wl + WO_W1), TS, N1, 1024}; pg8::StaticOrder S; S.init(TS, N1, G, bid);
              pg8::Epi1 E{(bf16_t*)(ws + OFF_GATES), (bf16_t*)(ws + OFF_APOOL), (bf16_t*)(ws + OFF_UV), (float*)(ws + OFF_RAW)};
              pg8::gemm_phase<pg8::Epi1, pg8::StaticOrder, true, true>(lds, g, S, E); }
            grid.sync();
            { PH_BEGIN pool_pass((const bf16_t*)(ws + OFF_APOOL), (bf16_t*)(ws + OFF_BR), G, bid); }
            { PH_BEGIN
              norm_pass((const float*)(ws + OFF_RAW), (bf16_t*)(ws + OFF_CQN), (bf16_t*)(ws + OFF_K192), (bf16_t*)(ws + OFF_VT), p->g_q + l * 256, p->g_kv + l * 128, (const float*)(ws + OFF_COS), (const float*)(ws + OFF_SIN), tok0, lds, G, bid); }
            { PH_BEGIN
              sgu_pass((const bf16_t*)(ws + OFF_UV), (bf16_t*)(ws + OFF_BR) + (size_t)2 * TS * 1024, (const bf16_t*)(ws + OFF_WSB) + (size_t)l * 8 * 128 * 128, p->b_s + l * 1024, p->g_sg + l * 1024, p->b_sg + l * 1024, lds, G, bid); }
            grid.sync();
            { PH_BEGIN const unsigned char* wl = ws + OFF_WL + (size_t)l * WL_STRIDE;
              int kq = 256; asm volatile("" : "+s"(kq));
              pg8::Gemm g{(const bf16_t*)(ws + OFF_CQN), (const bf16_t*)(wl + WO_WQ), TS, NQ, kq}; pg8::StaticOrder S; S.init(TS, NQ, G, bid);
              pg8::EpiQ E{(bf16_t*)(ws + OFF_QP), (const float*)(ws + OFF_COS), (const float*)(ws + OFF_SIN), tok0};
              pg8::gemm_phase<pg8::EpiQ, pg8::StaticOrder, true, true>(lds, g, S, E); }
            grid.sync();
            { PH_BEGIN
              attn_phase(lds, (const bf16_t*)(ws + OFF_QP), (const bf16_t*)(ws + OFF_K192), (const bf16_t*)(ws + OFF_VT), (bf16_t*)(ws + OFF_BR) + (size_t)TS * 1024, G, bid); }
            grid.sync();
            { PH_BEGIN const unsigned char* wl = ws + OFF_WL + (size_t)l * WL_STRIDE;
              pg8::Gemm g{(const bf16_t*)(ws + OFF_BR), (const bf16_t*)(wl + WO_WBR), 3 * TS, 3 * 1024, 1024}; pg8::BrOrder S; S.init(TS, G, bid);
              pg8::EpiBr E{(const bf16_t*)(ws + OFF_GATES), (float*)(ws + OFF_PART), (bf16_t*)(ws + OFF_H), TS / 256};
              pg8::gemm_phase<pg8::EpiBr, pg8::BrOrder, true, true>(lds, g, S, E); }
            grid.sync();
            { PH_BEGIN const unsigned char* wl = ws + OFF_WL + (size_t)l * WL_STRIDE; const float* modl = (const float*)(ws + OFF_MOD) + (size_t)l * 32 * 6144;
              pg8::Gemm g{(const bf16_t*)(ws + OFF_H), (const bf16_t*)(wl + WO_WO), TS, 1024, 1024}; pg8::StaticOrder S; S.init(TS, 1024, G, bid);
              pg8::EpiRes E{(l == 0) ? p->x : (const float*)p->out, p->out, modl + 2048, tok0};
              pg8::gemm_phase<pg8::EpiRes, pg8::StaticOrder, true, true>(lds, g, S, E); }
            grid.sync();
            { PH_BEGIN const float* modl = (const float*)(ws + OFF_MOD) + (size_t)l * 32 * 6144;
              ln_pass<1>(p->out, p->out, (bf16_t*)(ws + OFF_H), tok0, p->ln_t_g + l * 1024, p->ln_t_b + l * 1024, modl + 3072, modl + 4096, G, bid); }
            grid.sync();
            { PH_BEGIN const unsigned char* wl = ws + OFF_WL + (size_t)l * WL_STRIDE;
              pg8::Gemm g{(const bf16_t*)(ws + OFF_H), (const bf16_t*)(wl + WO_WUP), TS, NUP, 1024}; pg8::StaticOrder S; S.init(TS, NUP, G, bid); pg8::EpiUp E{(bf16_t*)(ws + OFF_Z), NUP};
              pg8::gemm_phase<pg8::EpiUp, pg8::StaticOrder, true, true>(lds, g, S, E); }
            grid.sync();
            { PH_BEGIN conv_pass((const bf16_t*)(ws + OFF_Z), (bf16_t*)(ws + OFF_FF), p->conv_w + (size_t)l * 3 * NUP, p->conv_b + (size_t)l * NUP, G, bid); }
            grid.sync();
            { PH_BEGIN const unsigned char* wl = ws + OFF_WL + (size_t)l * WL_STRIDE; const float* modl = (const float*)(ws + OFF_MOD) + (size_t)l * 32 * 6144;
              pg8::Gemm g{(const bf16_t*)(ws + OFF_FF), (const bf16_t*)(wl + WO_WDN), TS, 1024, DFF}; pg8::StaticOrder S; S.init(TS, 1024, G, bid); pg8::EpiRes E{p->out, p->out, modl + 5120, tok0};
              pg8::gemm_phase<pg8::EpiRes, pg8::StaticOrder, true, true>(lds, g, S, E); }
            grid.sync();
            { PH_BEGIN const float* mod1 = (const float*)(ws + OFF_MOD) + (size_t)32 * 6144;
              if (l == 0) ln_pass<1>(p->out, p->out, (bf16_t*)(ws + OFF_H), tok0, p->ln_f_g, p->ln_f_b, mod1, mod1 + 1024, G, bid);
              else ln_pass<1>(p->out, p->out, nullptr, tok0, p->ln_f_g + 1024, p->ln_f_b + 1024, nullptr, nullptr, G, bid); }
            grid.sync();
        }
    }
}

extern "C" void kernel_launch(void* const* d_in, const int* in_sizes, int n_in, void* d_out, int out_size, void* d_ws, size_t ws_size, hipStream_t stream) {
    static int grid = 0;
    if (grid == 0) {
        if (n_in != 26 || ws_size < WS_NEED) { fprintf(stderr, "kernel_launch: unexpected n_in %d / ws_size %zu\n", n_in, ws_size); grid = -1; return; }
        int dev = 0, cus = 0, per_cu = 0;
        if (hipGetDevice(&dev) != hipSuccess || hipDeviceGetAttribute(&cus, hipDeviceAttributeMultiprocessorCount, dev) != hipSuccess) { grid = -1; return; }
        if (hipFuncSetAttribute((const void*)mega_fwd, hipFuncAttributeMaxDynamicSharedMemorySize, LDS_BYTES) != hipSuccess) { fprintf(stderr, "kernel_launch: hipFuncSetAttribute failed\n"); grid = -1; return; }
        if (hipOccupancyMaxActiveBlocksPerMultiprocessor(&per_cu, (const void*)mega_fwd, 512, LDS_BYTES) != hipSuccess || per_cu < 1) { fprintf(stderr, "kernel_launch: occupancy query says %d\n", per_cu); per_cu = 1; }
        (void)hipGetLastError();
        grid = cus;
    }
    if (grid < 0) return;
    Params p{};
    const float** pf = (const float**)&p;
    p.x = (const float*)d_in[0]; p.c = (const float*)d_in[1]; p.pos = (const int*)d_in[2]; p.w_ada = (const float*)d_in[3]; p.b_ada = (const float*)d_in[4]; p.w_in = (const float*)d_in[5];
    p.w_pool = (const float*)d_in[6]; p.s_pool = (const float*)d_in[7]; p.g_q = (const float*)d_in[8]; p.w_uq = (const float*)d_in[9]; p.g_kv = (const float*)d_in[10]; p.w_ukv = (const float*)d_in[11];
    p.g_sg = (const float*)d_in[12]; p.b_sg = (const float*)d_in[13]; p.w_s = (const float*)d_in[14]; p.b_s = (const float*)d_in[15]; p.w_branch = (const float*)d_in[16]; p.w_o = (const float*)d_in[17];
    p.ln_t_g = (const float*)d_in[18]; p.ln_t_b = (const float*)d_in[19]; p.w_up = (const float*)d_in[20]; p.conv_w = (const float*)d_in[21]; p.conv_b = (const float*)d_in[22]; p.w_down = (const float*)d_in[23];
    p.ln_f_g = (const float*)d_in[24]; p.ln_f_b = (const float*)d_in[25];
    (void)pf;
    p.out = (float*)d_out; p.ws = (unsigned char*)d_ws;
    void* args[] = {&p};
    const hipError_t e = hipLaunchCooperativeKernel((const void*)mega_fwd, dim3(grid), dim3(512), args, LDS_BYTES, stream);
    if (e != hipSuccess) fprintf(stderr, "kernel_launch: cooperative launch failed: %s (grid %d)\n", hipGetErrorString(e), grid);
}
```

```cpp
#include <hip/hip_runtime.h>
#include <hip/hip_cooperative_groups.h>
#include <cstdio>
#include <cstdint>
namespace cg = cooperative_groups;
namespace pg8 {
#define PG8_LAS __attribute__((address_space(3)))
typedef unsigned short bf16_t;
typedef short bf16x8 __attribute__((ext_vector_type(8)));
typedef float f32x4 __attribute__((ext_vector_type(4)));
typedef unsigned u32x4 __attribute__((ext_vector_type(4)));
constexpr int BM = 256, BK = 64, HALF = 128, HTB = HALF * BK * 2  , STAGE_BYTES = 8 * HTB, NXCD = 8, WGM = 8;

__host__ __device__ __forceinline__ int lds_byte(int r, int c) { const int st = (r >> 4) * 2 + (c >> 5), rr = r & 15, cc = c & 31, ob = rr * 64 + cc * 2; return st * 1024 + (ob ^ (((ob >> 9) & 1) << 5)); }
__host__ __device__ __forceinline__ void stage_rc(int b, int& R, int& C) { const int st = b / 1024, sb = b % 1024, swz = sb ^ (((sb >> 9) & 1) << 5); R = (st >> 1) * 16 + swz / 64; C = (st & 1) * 32 + (swz % 64) / 2; }
__host__ __device__ __forceinline__ int perm32(int rho) { const int n = rho >> 4, i = rho & 15; return 8 * (i >> 2) + 4 * n + (i & 3); }

struct Unit { int pm, pn; };
struct Gemm { const bf16_t* A; const bf16_t* Bt; int M, N, K; };

struct StaticOrder {
    int nM, nN, nwg, G, c;
    __host__ __device__ void init(int M, int N, int G_, int c_) { nM = M / BM; nN = N / BM; nwg = nM * nN; G = G_; c = c_; }
    __host__ __device__ bool next(int i, Unit& u) const {
        const long L = (long)i * G + c; if (L >= nwg) return false;
        int wgid = (int)L; { const int q = nwg / NXCD, r = nwg % NXCD, xcd = wgid % NXCD, off = wgid / NXCD; wgid = (xcd < r ? xcd * (q + 1) : r * (q + 1) + (xcd - r) * q) + off; }
        const int nig = WGM * nN, gid = wgid / nig, fm = gid * WGM, gsz = (nM - fm) < WGM ? (nM - fm) : WGM;
        u.pm = fm + ((wgid % nig) % gsz); u.pn = (wgid % nig) / gsz; return true;
    }
    __device__ __forceinline__ void a_ready(const Unit&) const {}
    __device__ __forceinline__ void done(const Unit&) const {}
};


typedef float f32x2 __attribute__((ext_vector_type(2)));
typedef __bf16 bfv2 __attribute__((ext_vector_type(2)));
typedef unsigned u32x2 __attribute__((ext_vector_type(2)));
__device__ __forceinline__ unsigned pk2(float a, float b) { f32x2 v = {a, b}; bfv2 r = __builtin_convertvector(v, bfv2); return __builtin_bit_cast(unsigned, r); }
__device__ __forceinline__ float bf_lo(unsigned w) { return __uint_as_float(w << 16); }
__device__ __forceinline__ float bf_hi(unsigned w) { return __uint_as_float(w & 0xffff0000u); }
__device__ __forceinline__ u32x4 pack8(const f32x4 a, const f32x4 b) { u32x4 w; w.x = pk2(a[0], a[1]); w.y = pk2(a[2], a[3]); w.z = pk2(b[0], b[1]); w.w = pk2(b[2], b[3]); return w; }
__device__ __forceinline__ f32x2 gelu_pk(f32x2 v) {
    const f32x2 av = __builtin_elementwise_abs(v), d = av * 0.2316418882f + 1.0f;
    f32x2 t; t.x = __builtin_amdgcn_rcpf(d.x); t.y = __builtin_amdgcn_rcpf(d.y);
    f32x2 q = t * 0.5307027145f + (-0.7265760135f); q = q * t + 0.7107068705f; q = q * t + (-0.142248368f); q = q * t + 0.127414796f; q = q * t;
    const f32x2 s = (v * v) * (-0.72134752044f);
    f32x2 e; e.x = __builtin_amdgcn_exp2f(s.x); e.y = __builtin_amdgcn_exp2f(s.y);
    const f32x2 m = v * (q * e), r = v - m;
    f32x2 o; o.x = v.x < 0.f ? m.x : r.x; o.y = v.y < 0.f ? m.y : r.y; return o;
}
__device__ __forceinline__ f32x4 gelu4(f32x4 v) { const f32x2 a = gelu_pk((f32x2){v[0], v[1]}), b = gelu_pk((f32x2){v[2], v[3]}); return (f32x4){a.x, a.y, b.x, b.y}; }
__device__ __forceinline__ float sigm(float x) { return __builtin_amdgcn_rcpf(1.0f + __builtin_amdgcn_exp2f(-1.4426950408889634f * x)); }
__device__ __forceinline__ f32x4 sigm4(f32x4 v) { return (f32x4){sigm(v[0]), sigm(v[1]), sigm(v[2]), sigm(v[3])}; }

struct Epi1 {
    static constexpr bool PERM = true, AFTER_DRAIN = false;
    bf16_t* gates; bf16_t* apool; bf16_t* uv; float* raw;
    __device__ __forceinline__ void operator()(const f32x4 (&acc)[2][2][4][2], const Unit& u, int wr, int wc, int fr, int fq) const {
        const int row0 = u.pm * BM + wr * 64 + fr, cl = wc * 32 + 8 * fq, pn = u.pn;
        if (pn < 24) {
            bf16_t* base; int ldc, col0, act;
            if (pn < 12) { base = gates; ldc = 3072; col0 = pn * 256; act = 1; }
            else if (pn < 16) { base = apool; ldc = 1024; col0 = (pn - 12) * 256; act = 0; }
            else { base = uv; ldc = 2048; col0 = (pn - 16) * 256; act = 2; }
#pragma unroll
            for (int ai = 0; ai < 2; ++ai)
#pragma unroll
                for (int m = 0; m < 4; ++m) { bf16_t* rowp = base + (size_t)(row0 + ai * HALF + m * 16) * ldc + col0 + cl;
#pragma unroll
                    for (int bj = 0; bj < 2; ++bj) { f32x4 v0 = acc[ai][bj][m][0], v1 = acc[ai][bj][m][1];
                        if (act == 1) { v0 = sigm4(v0); v1 = sigm4(v1); }
                        else if (act == 2) { v0 = gelu4(v0); v1 = gelu4(v1); }
                        *(u32x4*)(rowp + bj * HALF) = pack8(v0, v1); } }
        } else {
            float* base = raw + (pn - 24) * 256 + cl;
#pragma unroll
            for (int ai = 0; ai < 2; ++ai)
#pragma unroll
                for (int m = 0; m < 4; ++m) { float* rowp = base + (size_t)(row0 + ai * HALF + m * 16) * 512;
#pragma unroll
                    for (int bj = 0; bj < 2; ++bj) { *(f32x4*)(rowp + bj * HALF) = acc[ai][bj][m][0]; *(f32x4*)(rowp + bj * HALF + 4) = acc[ai][bj][m][1]; } }
        }
    }
};
struct EpiQ {
    static constexpr bool PERM = true, AFTER_DRAIN = false;
    bf16_t* qp; const float* cosT; const float* sinT; int tok0;
    __device__ __forceinline__ void operator()(const f32x4 (&acc)[2][2][4][2], const Unit& u, int wr, int wc, int fr, int fq) const {
        const float SC = 0.10411754627697264f;
        const int row0 = u.pm * BM + wr * 64 + fr;
        if (u.pn < 4) {
#pragma unroll
            for (int ai = 0; ai < 2; ++ai)
#pragma unroll
                for (int m = 0; m < 4; ++m) { bf16_t* rowp = qp + (size_t)(row0 + ai * HALF + m * 16) * 1536 + wc * 32 + 8 * fq;
#pragma unroll
                    for (int bj = 0; bj < 2; ++bj) *(u32x4*)(rowp + (2 * u.pn + bj) * 192) = pack8(acc[ai][bj][m][0] * SC, acc[ai][bj][m][1] * SC); }
        } else {
            const int h = 4 * (u.pn - 4) + wc;
#pragma unroll
            for (int ai = 0; ai < 2; ++ai)
#pragma unroll
                for (int m = 0; m < 4; ++m) { const int row = row0 + ai * HALF + m * 16;
#pragma unroll
                    for (int n = 0; n < 2; ++n) { const int i0 = 8 * fq + 4 * n; const size_t tr = (size_t)(tok0 + row) * 32 + i0;
                        const f32x4 c0 = *(const f32x4*)(cosT + tr) * SC, s0 = *(const f32x4*)(sinT + tr) * SC, x1 = acc[ai][0][m][n], x2 = acc[ai][1][m][n];
                        const f32x4 o1 = x1 * c0 - x2 * s0, o2 = x2 * c0 + x1 * s0;
                        bf16_t* rowp = qp + (size_t)row * 1536 + h * 192 + 128 + i0;
                        u32x2 w1; w1.x = pk2(o1[0], o1[1]); w1.y = pk2(o1[2], o1[3]); u32x2 w2; w2.x = pk2(o2[0], o2[1]); w2.y = pk2(o2[2], o2[3]);
                        *(u32x2*)(rowp) = w1; *(u32x2*)(rowp + 32) = w2; }
                    asm volatile("" ::: "memory"); }
        }
    }
};
struct EpiBr {
    static constexpr bool PERM = true, AFTER_DRAIN = false;
    const bf16_t* gates; float* part; bf16_t* merged; int nM;
    __device__ __forceinline__ void operator()(const f32x4 (&acc)[2][2][4][2], const Unit& u, int wr, int wc, int fr, int fq) const {
        const int br = u.pn >> 2, pn = u.pn & 3, pm = u.pm - br * nM;
        const int row0 = pm * BM + wr * 64 + fr, cl = pn * 256 + wc * 32 + 8 * fq;
#pragma unroll
        for (int ai = 0; ai < 2; ++ai)
#pragma unroll
            for (int mp = 0; mp < 2; ++mp) {
                u32x4 gw[2][2]; f32x4 p0[2][2], p1[2][2];
#pragma unroll
                for (int mm = 0; mm < 2; ++mm) { const size_t row = (size_t)(row0 + ai * HALF + (2 * mp + mm) * 16);
#pragma unroll
                    for (int bj = 0; bj < 2; ++bj) { const int col = cl + bj * HALF; gw[mm][bj] = *(const u32x4*)(gates + row * 3072 + br * 1024 + col);
                        if (br != 0) { p0[mm][bj] = *(const f32x4*)(part + row * 1024 + col); p1[mm][bj] = *(const f32x4*)(part + row * 1024 + col + 4); } } }
                asm volatile("" ::: "memory"); __builtin_amdgcn_sched_barrier(0);
#pragma unroll
                for (int mm = 0; mm < 2; ++mm) { const int m = 2 * mp + mm; const size_t row = (size_t)(row0 + ai * HALF + m * 16);
#pragma unroll
                    for (int bj = 0; bj < 2; ++bj) { const int col = cl + bj * HALF; const u32x4 g = gw[mm][bj];
                        f32x4 v0 = acc[ai][bj][m][0] * (f32x4){bf_lo(g.x), bf_hi(g.x), bf_lo(g.y), bf_hi(g.y)};
                        f32x4 v1 = acc[ai][bj][m][1] * (f32x4){bf_lo(g.z), bf_hi(g.z), bf_lo(g.w), bf_hi(g.w)};
                        if (br != 0) { v0 += p0[mm][bj]; v1 += p1[mm][bj]; }
                        if (br != 2) { float* pp = part + row * 1024 + col; *(f32x4*)pp = v0; *(f32x4*)(pp + 4) = v1; }
                        else *(u32x4*)(merged + row * 1024 + col) = pack8(v0, v1); } }
            }
    }
};
struct EpiRes {
    static constexpr bool PERM = false, AFTER_DRAIN = false;
    const float* xin; float* xout; const float* gate; int tok0;
    __device__ __forceinline__ void operator()(const f32x4 (&acc)[2][2][4][2], const Unit& u, int wr, int wc, int fr, int fq) const {
        const float ALPHA = 1.4142135623730951f;
        const int grow0 = tok0 + u.pm * BM + wr * 64 + fr, col0 = u.pn * BM + wc * 32 + 4 * fq;
        const float* gp = gate + (size_t)((tok0 + u.pm * BM) >> 11) * 6144 + col0;
        f32x4 gv[2][2];
#pragma unroll
        for (int bj = 0; bj < 2; ++bj)
#pragma unroll
            for (int n = 0; n < 2; ++n) gv[bj][n] = *(const f32x4*)(gp + bj * HALF + n * 16);
#pragma unroll
        for (int ai = 0; ai < 2; ++ai)
#pragma unroll
            for (int m = 0; m < 4; ++m) { const size_t off = (size_t)(grow0 + ai * HALF + m * 16) * 1024 + col0;
#pragma unroll
                for (int bj = 0; bj < 2; ++bj)
#pragma unroll
                    for (int n = 0; n < 2; ++n) { const f32x4 xv = *(const f32x4*)(xin + off + bj * HALF + n * 16); *(f32x4*)(xout + off + bj * HALF + n * 16) = xv * ALPHA + gv[bj][n] * acc[ai][bj][m][n]; } }
    }
};
struct EpiUp {
    static constexpr bool PERM = true, AFTER_DRAIN = false;
    bf16_t* z; int ldc;
    __device__ __forceinline__ void operator()(const f32x4 (&acc)[2][2][4][2], const Unit& u, int wr, int wc, int fr, int fq) const {
        const int row0 = u.pm * BM + wr * 64 + fr, col0 = u.pn * BM + wc * 32 + 8 * fq;
#pragma unroll
        for (int ai = 0; ai < 2; ++ai)
#pragma unroll
            for (int m = 0; m < 4; ++m) { bf16_t* rowp = z + (size_t)(row0 + ai * HALF + m * 16) * ldc + col0;
#pragma unroll
                for (int bj = 0; bj < 2; ++bj) *(u32x4*)(rowp + bj * HALF) = pack8(acc[ai][bj][m][0], acc[ai][bj][m][1]); }
    }
};
__device__ __forceinline__ f32x4 dpp_ror(const f32x4 v, const int n) {
    const int lane = (int)(threadIdx.x & 63), src = ((lane & ~15) | ((lane - n) & 15)) << 2;
    f32x4 r;
#pragma unroll
    for (int j = 0; j < 4; ++j) r[j] = __builtin_bit_cast(float, __builtin_amdgcn_ds_bpermute(src, __builtin_bit_cast(int, v[j])));
    return r;
}
struct EpiUpConv {
    static constexpr bool PERM = true, AFTER_DRAIN = false;
    bf16_t* ff; float* zb; const float* cw; const float* cb;
    __device__ __forceinline__ void operator()(const f32x4 (&acc)[2][2][4][2], const Unit& u, int wr, int wc, int fr, int fq) const {
        const int cofs = 32 * wc + 8 * fq, colv0 = 128 * u.pn + cofs, zcol0 = 256 * u.pn + cofs;
        const bool f0 = (fr == 0), f01 = (fr < 2);
#pragma unroll
        for (int ai = 0; ai < 2; ++ai) {
            const int rowbase = u.pm * BM + ai * HALF + wr * 64, gi = rowbase >> 6;
#pragma unroll
            for (int n = 0; n < 2; ++n) {
                const float* pv = cw + colv0 + 4 * n; const float* pg = pv + 2816;
                const f32x4 wv0 = *(const f32x4*)pv, wv1 = *(const f32x4*)(pv + 5632), wv2 = *(const f32x4*)(pv + 2 * 5632), bv = *(const f32x4*)(cb + colv0 + 4 * n);
                const f32x4 wg0 = *(const f32x4*)pg, wg1 = *(const f32x4*)(pg + 5632), wg2 = *(const f32x4*)(pg + 2 * 5632), bg = *(const f32x4*)(cb + 2816 + colv0 + 4 * n);
                f32x4 p1v = {0.f, 0.f, 0.f, 0.f}, p2v = p1v, p1g = p1v, p2g = p1v;
#pragma unroll
                for (int m = 0; m < 4; ++m) { const f32x4 zv = acc[ai][0][m][n], zg = acc[ai][1][m][n];
                    const f32x4 t1v = dpp_ror(zv, 1), t2v = dpp_ror(zv, 2), t1g = dpp_ror(zg, 1), t2g = dpp_ror(zg, 2);
                    f32x4 vc = bv + wv2 * zv, gc = bg + wg2 * zg;
#pragma unroll
                    for (int j = 0; j < 4; ++j) { vc[j] += wv1[j] * (f0 ? p1v[j] : t1v[j]) + wv0[j] * (f01 ? p2v[j] : t2v[j]); gc[j] += wg1[j] * (f0 ? p1g[j] : t1g[j]) + wg0[j] * (f01 ? p2g[j] : t2g[j]); }
                    const f32x4 o = gc * sigm4(gc) * vc;
                    if (m > 0 || !f01) { u32x2 w; w.x = pk2(o[0], o[1]); w.y = pk2(o[2], o[3]); *(u32x2*)(ff + (size_t)(rowbase + 16 * m + fr) * 2816 + colv0 + 4 * n) = w; }
                    p1v = t1v; p2v = t2v; p1g = t1g; p2g = t2g; }
                asm volatile("" ::: "memory");
            }
            if (f01) { float* zp = zb + ((size_t)gi * 4 + fr) * 5632 + zcol0;
#pragma unroll
                for (int bj = 0; bj < 2; ++bj) { *(f32x4*)(zp + bj * HALF) = acc[ai][bj][0][0]; *(f32x4*)(zp + bj * HALF + 4) = acc[ai][bj][0][1]; } }
            if (fr >= 14) { float* zp = zb + ((size_t)gi * 4 + (fr - 12)) * 5632 + zcol0;
#pragma unroll
                for (int bj = 0; bj < 2; ++bj) { *(f32x4*)(zp + bj * HALF) = acc[ai][bj][3][0]; *(f32x4*)(zp + bj * HALF + 4) = acc[ai][bj][3][1]; } }
        }
    }
};
struct BrOrder {
    StaticOrder base; int nM;
    __device__ void init(int M, int G_, int c_) { base.init(M, 1024, G_, c_); nM = M / BM; }
    __device__ bool next(int i, Unit& u) const { const int ti = i / 3, br = i - 3 * ti; Unit t; if (!base.next(ti, t)) return false; u.pm = br * nM + t.pm; u.pn = br * 4 + t.pn; return true; }
    __device__ __forceinline__ void a_ready(const Unit&) const {}
    __device__ __forceinline__ void done(const Unit&) const {}
};

template <class Epi, class Sched, bool ALIGN_EPI = false, bool SP2 = false>
__device__ __forceinline__ void gemm_phase(PG8_LAS unsigned char* lds, const Gemm g, const Sched& S, const Epi& E) {
    int tid_ = threadIdx.x; asm volatile("" : "+v"(tid_));
    const int tid = tid_, wid = __builtin_amdgcn_readfirstlane(tid >> 6), lane = tid & 63, wr = wid >> 2, wc = wid & 3, fr = lane & 15, fq = lane >> 4;
    const int K = g.K, nt = K / BK;
    unsigned voffA[2], voffB[2];
#pragma unroll
    for (int i = 0; i < 2; ++i) { int R, C; stage_rc(tid * 16 + i * 8192, R, C); const int Rb = Epi::PERM ? ((R & ~31) + perm32(R & 31)) : R;
        voffA[i] = (unsigned)(R * K + C) * 2u; voffB[i] = (unsigned)(Rb * K + C) * 2u; }
    const size_t kstep = (size_t)(BK * 2);
    const size_t hstep = (size_t)HALF * K * 2;
    const size_t tstep = 2 * hstep;
    const unsigned ldsw = (unsigned)wid * 1024u;
    const int aoff = lds_byte(wr * 64 + fr, fq * 8), boff = lds_byte(wc * 32 + fr, fq * 8);
#define PG8_SA(b, h) (((b) * 2 + (h)) * HTB)
#define PG8_SB(b, h) ((4 + (b) * 2 + (h)) * HTB)
#define PG8_STAGE(bufoff, gbase, voff) do { _Pragma("unroll") for (int _i = 0; _i < 2; ++_i) \
        __builtin_amdgcn_global_load_lds((const unsigned*)((const char*)(gbase) + (voff)[_i]), (PG8_LAS unsigned*)(lds + (bufoff) + ldsw + _i * 8192), 16, 0, 0); } while (0)
#define PG8_LDA(dst, b, h) do { _Pragma("unroll") for (int m = 0; m < 4; ++m) _Pragma("unroll") for (int k = 0; k < 2; ++k) dst[m][k] = *(const PG8_LAS bf16x8*)(lds + PG8_SA(b, h) + aoff + m * 2048 + k * 1024); } while (0)
#define PG8_LDB(dst, b, h) do { _Pragma("unroll") for (int n = 0; n < 2; ++n) _Pragma("unroll") for (int k = 0; k < 2; ++k) dst[n][k] = *(const PG8_LAS bf16x8*)(lds + PG8_SB(b, h) + boff + n * 2048 + k * 1024); } while (0)
#define PG8_MMA(ai, bj, At, Bt) do { __builtin_amdgcn_s_setprio(1); _Pragma("unroll") for (int m = 0; m < 4; ++m) _Pragma("unroll") for (int n = 0; n < 2; ++n) _Pragma("unroll") for (int k = 0; k < 2; ++k) \
        acc[ai][bj][m][n] = __builtin_amdgcn_mfma_f32_16x16x32_bf16(Bt[n][k], At[m][k], acc[ai][bj][m][n], 0, 0, 0); __builtin_amdgcn_s_setprio(0); } while (0)
#define PG8_WAIT_V(n) asm volatile("s_waitcnt vmcnt(" #n ")" ::: "memory")
#define PG8_WAIT_L(n) asm volatile("s_waitcnt lgkmcnt(" #n ")" ::: "memory")
#define PG8_BAR __builtin_amdgcn_s_barrier()
#define PG8_SCHED __builtin_amdgcn_sched_barrier(0)
    Unit cur, nxt; int ui = 0;
    if (!S.next(0, cur)) return;
    f32x4 acc[2][2][4][2];
#pragma unroll
    for (int a = 0; a < 2; ++a)
#pragma unroll
        for (int b = 0; b < 2; ++b)
#pragma unroll
            for (int m = 0; m < 4; ++m)
#pragma unroll
                for (int n = 0; n < 2; ++n) acc[a][b][m][n] = (f32x4){0.f, 0.f, 0.f, 0.f};
    bf16x8 At[4][2], B0[2][2], B1[2][2];
    const char* cA = (const char*)g.A + (size_t)cur.pm * tstep; const char* cB = (const char*)g.Bt + (size_t)cur.pn * tstep;
    S.a_ready(cur);
    if constexpr (SP2) {
        PG8_STAGE(PG8_SB(0, 0), cB, voffB); PG8_STAGE(PG8_SB(0, 1), cB + hstep, voffB); PG8_STAGE(PG8_SA(0, 0), cA, voffA); PG8_STAGE(PG8_SA(0, 1), cA + hstep, voffA);
        if (wr == 1) PG8_BAR;
        PG8_WAIT_V(2); PG8_BAR;
        PG8_STAGE(PG8_SB(1, 0), cB + kstep, voffB); PG8_STAGE(PG8_SA(1, 0), cA + kstep, voffA); PG8_STAGE(PG8_SB(1, 1), cB + hstep + kstep, voffB);
        PG8_WAIT_V(6); PG8_BAR;
    } else {
        PG8_STAGE(PG8_SB(0, 0), cB, voffB); PG8_STAGE(PG8_SA(0, 0), cA, voffA); PG8_STAGE(PG8_SB(0, 1), cB + hstep, voffB); PG8_STAGE(PG8_SA(0, 1), cA + hstep, voffA);
        if (wr == 1) PG8_BAR;
        PG8_WAIT_V(4); PG8_BAR;
        PG8_STAGE(PG8_SB(1, 0), cB + kstep, voffB); PG8_STAGE(PG8_SA(1, 0), cA + kstep, voffA); PG8_STAGE(PG8_SB(1, 1), cB + hstep + kstep, voffB);
        PG8_WAIT_V(6); PG8_BAR;
    }
    for (;;) {
        const bool has_next = S.next(ui + 1, nxt);
        const char* nA = has_next ? (const char*)g.A + (size_t)nxt.pm * tstep : cA; const char* nB = has_next ? (const char*)g.Bt + (size_t)nxt.pn * tstep : cB;
        for (int t = 0; t < nt; t += 2) {
            const bool last = (t == nt - 2);
            const char* a1 = cA + (size_t)(t + 1) * kstep;
            const char* a2 = last ? nA : cA + (size_t)(t + 2) * kstep; const char* b2 = last ? nB : cB + (size_t)(t + 2) * kstep;
            const char* a3 = a2 + kstep; const char* b3 = b2 + kstep;
            if (last && has_next) S.a_ready(nxt);
            if constexpr (SP2) {
            PG8_LDB(B0, 0, 0); PG8_LDB(B1, 0, 1); PG8_SCHED; PG8_LDA(At, 0, 0); PG8_STAGE(PG8_SA(1, 1), a1 + hstep, voffA);
            PG8_WAIT_V(8); PG8_WAIT_L(0); PG8_BAR; PG8_MMA(0, 0, At, B0); PG8_MMA(0, 1, At, B1); PG8_BAR; PG8_SCHED;
            PG8_LDA(At, 0, 1); PG8_STAGE(PG8_SB(0, 0), b2, voffB); PG8_STAGE(PG8_SB(0, 1), b2 + hstep, voffB); PG8_STAGE(PG8_SA(0, 0), a2, voffA);
            PG8_WAIT_V(8); PG8_WAIT_L(0); PG8_BAR; PG8_MMA(1, 0, At, B0); PG8_MMA(1, 1, At, B1); PG8_BAR; PG8_SCHED;
            PG8_LDB(B0, 1, 0); PG8_LDB(B1, 1, 1); PG8_SCHED; PG8_LDA(At, 1, 0); PG8_STAGE(PG8_SA(0, 1), a2 + hstep, voffA);
            PG8_WAIT_V(8); PG8_WAIT_L(0); PG8_BAR; PG8_MMA(0, 0, At, B0); PG8_MMA(0, 1, At, B1); PG8_BAR; PG8_SCHED;
            PG8_LDA(At, 1, 1); PG8_STAGE(PG8_SB(1, 0), b3, voffB); PG8_STAGE(PG8_SB(1, 1), b3 + hstep, voffB); PG8_STAGE(PG8_SA(1, 0), a3, voffA);
            PG8_WAIT_V(8); PG8_WAIT_L(0); PG8_BAR; PG8_MMA(1, 0, At, B0); PG8_MMA(1, 1, At, B1); PG8_BAR; PG8_SCHED;
            } else {
            PG8_LDB(B0, 0, 0); PG8_SCHED; PG8_LDA(At, 0, 0); PG8_STAGE(PG8_SA(1, 1), a1 + hstep, voffA);
            PG8_WAIT_L(8); PG8_BAR; PG8_WAIT_L(0); PG8_MMA(0, 0, At, B0); PG8_BAR; PG8_SCHED;
            PG8_LDB(B1, 0, 1); PG8_STAGE(PG8_SB(0, 0), b2, voffB);
            PG8_BAR; PG8_WAIT_L(0); PG8_MMA(0, 1, At, B1); PG8_BAR;
            PG8_LDA(At, 0, 1); PG8_STAGE(PG8_SA(0, 0), a2, voffA);
            PG8_BAR; PG8_WAIT_L(0); PG8_MMA(1, 0, At, B0); PG8_BAR; PG8_SCHED;
            PG8_STAGE(PG8_SB(0, 1), b2 + hstep, voffB);
            PG8_WAIT_V(6); PG8_BAR; PG8_MMA(1, 1, At, B1); PG8_BAR;
            PG8_LDB(B0, 1, 0); PG8_SCHED; PG8_LDA(At, 1, 0); PG8_STAGE(PG8_SA(0, 1), a2 + hstep, voffA);
            PG8_WAIT_L(8); PG8_BAR; PG8_WAIT_L(0); PG8_MMA(0, 0, At, B0); PG8_BAR; PG8_SCHED;
            PG8_LDB(B1, 1, 1); PG8_STAGE(PG8_SB(1, 0), b3, voffB);
            PG8_BAR; PG8_WAIT_L(0); PG8_MMA(0, 1, At, B1); PG8_BAR;
            PG8_LDA(At, 1, 1); PG8_STAGE(PG8_SA(1, 0), a3, voffA);
            PG8_BAR; PG8_WAIT_L(0); PG8_MMA(1, 0, At, B0); PG8_BAR; PG8_SCHED;
            PG8_STAGE(PG8_SB(1, 1), b3 + hstep, voffB);
            PG8_WAIT_V(6); PG8_BAR; PG8_MMA(1, 1, At, B1); PG8_BAR;
            }
        }
        if constexpr (ALIGN_EPI) { if (wr == 0) PG8_BAR; }
        if constexpr (!Epi::AFTER_DRAIN) { E(acc, cur, wr, wc, fr, fq); S.done(cur); }
        if (!has_next) break;
#pragma unroll
        for (int a = 0; a < 2; ++a)
#pragma unroll
            for (int b = 0; b < 2; ++b)
#pragma unroll
                for (int m = 0; m < 4; ++m)
#pragma unroll
                    for (int n = 0; n < 2; ++n) acc[a][b][m][n] = (f32x4){0.f, 0.f, 0.f, 0.f};
        cur = nxt; cA = nA; cB = nB; ++ui;
        if constexpr (ALIGN_EPI) { if (wr == 1) PG8_BAR; }
    }
    PG8_WAIT_V(0);
    if constexpr (!ALIGN_EPI) { if (wr == 0) PG8_BAR; }
    PG8_BAR;
    if constexpr (Epi::AFTER_DRAIN) { E.fused(acc, cur, wr, wc, fr, fq, lds, wid, lane); S.done(cur); }
#undef PG8_SA
#undef PG8_SB
#undef PG8_STAGE
#undef PG8_LDA
#undef PG8_LDB
#undef PG8_MMA
#undef PG8_WAIT_V
#undef PG8_WAIT_L
#undef PG8_BAR
#undef PG8_SCHED
}
}


#define LAS __attribute__((address_space(3)))
typedef unsigned short bf16_t;
typedef float f32x4 __attribute__((ext_vector_type(4)));
typedef float f32x16 __attribute__((ext_vector_type(16)));
typedef unsigned u32x4 __attribute__((ext_vector_type(4)));
typedef unsigned u32x2 __attribute__((ext_vector_type(2)));
typedef short bf16x8 __attribute__((ext_vector_type(8)));
typedef short s16x4 __attribute__((ext_vector_type(4)));
using pg8::pk2; using pg8::bf_lo; using pg8::bf_hi; using pg8::pack8;

constexpr int T_ALL = 65536, SEQ = 2048, NBATCH = 32, DM = 1024, NS = 2, TS = T_ALL / NS, BPS = NBATCH / NS;
constexpr int IN_W = 6592, N1 = 6656, NQ = 1536, DFF = 2816, NUP = 5632;
constexpr size_t MiB = 1u << 20;
constexpr size_t OFF_MOD = 0, OFF_COS = 2 * MiB, OFF_SIN = 10 * MiB, OFF_WSB = 18 * MiB, OFF_WL = 20 * MiB, WL_STRIDE = 40 * MiB;
constexpr size_t WO_W1 = 0, WO_WQ = 13 * MiB, WO_WBR = 14 * MiB, WO_WO = 20 * MiB, WO_WUP = 22 * MiB, WO_WDN = 33 * MiB;
constexpr size_t OFF_H = 128 * MiB, OFF_GATES = 192 * MiB, OFF_APOOL = 384 * MiB, OFF_RAW = 448 * MiB, OFF_PART = 384 * MiB, OFF_UV = 512 * MiB, OFF_QP = 512 * MiB,
                 OFF_BR = 640 * MiB, OFF_CQN = 832 * MiB, OFF_K192 = 848 * MiB, OFF_VT = 860 * MiB, OFF_Z = 192 * MiB, OFF_FF = 544 * MiB, OFF_Y = 720 * MiB, WS_NEED = 868 * MiB;
constexpr int LDS_BYTES = 147456, LDS_BARST = 131072 + 256;
constexpr size_t OFF_BAR = 1835008, BAR_BYTES = 16384;
constexpr float LN_EPS = 1e-5f, RMS_EPS = 1e-6f;

struct Params {
    const float* x; const float* c; const int* pos; const float* w_ada; const float* b_ada; const float* w_in; const float* w_pool; const float* s_pool; const float* g_q; const float* w_uq;
    const float* g_kv; const float* w_ukv; const float* g_sg; const float* b_sg; const float* w_s; const float* b_s; const float* w_branch; const float* w_o; const float* ln_t_g; const float* ln_t_b;
    const float* w_up; const float* conv_w; const float* conv_b; const float* w_down; const float* ln_f_g; const float* ln_f_b;
    float* out; unsigned char* ws;
};

#define LOADS_DONE() do { asm volatile("" ::: "memory"); __builtin_amdgcn_sched_barrier(0); } while (0)
__device__ __forceinline__ int tid_opaque() { int t = threadIdx.x; asm volatile("" : "+v"(t)); return t; }
__device__ __forceinline__ float dpp_f(float v, const int ctrl_sel) {
    const int x = __builtin_bit_cast(int, v); int r;
    if (ctrl_sel == 0) r = __builtin_amdgcn_update_dpp(0, x, 0xB1, 0xF, 0xF, true);
    else if (ctrl_sel == 1) r = __builtin_amdgcn_update_dpp(0, x, 0x4E, 0xF, 0xF, true);
    else if (ctrl_sel == 2) r = __builtin_amdgcn_update_dpp(0, x, 0x141, 0xF, 0xF, true);
    else r = __builtin_amdgcn_update_dpp(0, x, 0x140, 0xF, 0xF, true);
    return __builtin_bit_cast(float, r);
}
__device__ __forceinline__ float wave_sum(float v) {
    v += dpp_f(v, 0); v += dpp_f(v, 1); v += dpp_f(v, 2); v += dpp_f(v, 3);
    const int x = __builtin_bit_cast(int, v);
    const float r0 = __builtin_bit_cast(float, __builtin_amdgcn_readlane(x, 0)), r1 = __builtin_bit_cast(float, __builtin_amdgcn_readlane(x, 16)),
                r2 = __builtin_bit_cast(float, __builtin_amdgcn_readlane(x, 32)), r3 = __builtin_bit_cast(float, __builtin_amdgcn_readlane(x, 48));
    return (r0 + r1) + (r2 + r3);
}

#define XB_TMO      128
#define XB_XCNT(j)  (256  + 64 * (j))
#define XB_XSUB(j)  (1280 + 64 * (j))
#define XB_XGEN(j)  (2304 + 64 * (j))
#define XB_TOP      3328
#define XB_TOPGEN   3392
#define XCD_BAR_WORDS 3456
#define XB_SPIN_CAP (1u << 18)

__device__ __forceinline__ unsigned xb_ld(unsigned* p)              { return __hip_atomic_load(p, __ATOMIC_RELAXED, __HIP_MEMORY_SCOPE_AGENT); }
__device__ __forceinline__ unsigned xb_add(unsigned* p, unsigned v) { return __hip_atomic_fetch_add(p, v, __ATOMIC_RELAXED, __HIP_MEMORY_SCOPE_AGENT); }
__device__ __forceinline__ unsigned xb_xcc_id() { return (unsigned)__builtin_amdgcn_s_getreg((3 << 11) | 20) & 0xFu; }
#define XB_SPIN(cond, bar) do { unsigned _sp = 0; while (cond) { __builtin_amdgcn_s_sleep(1); \
    if ((++_sp & 255u) == 0u) { if (xb_ld(&(bar)[XB_TMO])) break; if (_sp > XB_SPIN_CAP) { atomicAdd(&(bar)[XB_TMO], 1u); break; } } } } while (0)

struct XcdBarrier {
    unsigned* bar; unsigned x;
    volatile LAS unsigned* st;
};

__device__ __forceinline__ XcdBarrier xcd_barrier_post(unsigned* bar, volatile LAS unsigned* st) {
    XcdBarrier b; b.bar = bar; b.x = xb_xcc_id(); b.st = st;
    if (threadIdx.x == 0) (void)xb_add(&bar[XB_XCNT(b.x)], 1u);
    return b;
}
__device__ __forceinline__ void xcd_barrier_complete(unsigned* bar, unsigned x, unsigned& nloc, unsigned& nx) {
    const unsigned G = gridDim.x * gridDim.y * gridDim.z;
    unsigned sum, cnt, mine, sp = 0u;
    for (;;) {
        sum = 0u; cnt = 0u; mine = 0u;
#pragma unroll
        for (unsigned j = 0; j < 16; ++j) { const unsigned c = xb_ld(&bar[XB_XCNT(j)]); sum += c; cnt += (c > 0u) ? 1u : 0u; mine = (j == x) ? c : mine; }
        if (sum == G) break;
        __builtin_amdgcn_s_sleep(1);
        if ((++sp & 255u) == 0u) { if (xb_ld(&bar[XB_TMO])) break; if (sp > XB_SPIN_CAP) { atomicAdd(&bar[XB_TMO], 1u); break; } }
    }
    nloc = mine > 0u ? mine : 1u; nx = cnt > 0u ? cnt : 1u;
}

__device__ __forceinline__ void xcd_barrier(const XcdBarrier& b) {
    asm volatile("s_waitcnt vmcnt(0)" ::: "memory");
    __syncthreads();
    if (threadIdx.x == 0) {
        unsigned* bar = b.bar;
        __builtin_amdgcn_s_waitcnt(0);
        unsigned nloc = b.st[0], nx = b.st[1];
        if (nloc == 0u) { xcd_barrier_complete(bar, b.x, nloc, nx); b.st[0] = nloc; b.st[1] = nx; }
        const unsigned old = xb_add(&bar[XB_XSUB(b.x)], 1u);
        const unsigned gen = old / nloc;
        if (old + 1u == (gen + 1u) * nloc) {
            __builtin_amdgcn_fence(__ATOMIC_RELEASE, "agent");
            asm volatile("s_waitcnt vmcnt(0)" ::: "memory");
            const unsigned og = xb_add(&bar[XB_TOP], 1u);
            const unsigned tg = og / nx;
            if (og + 1u == (tg + 1u) * nx) xb_add(&bar[XB_TOPGEN], 1u);
            else XB_SPIN(xb_ld(&bar[XB_TOPGEN]) == tg, bar);
            __builtin_amdgcn_fence(__ATOMIC_ACQUIRE, "agent");
            xb_add(&bar[XB_XGEN(b.x)], 1u);
            asm volatile("s_waitcnt vmcnt(0)" ::: "memory");
        } else {
            XB_SPIN(xb_ld(&bar[XB_XGEN(b.x)]) == gen, bar);
            __builtin_amdgcn_fence(__ATOMIC_ACQUIRE, "agent");
            asm volatile("s_waitcnt vmcnt(0)" ::: "memory");
        }
    }
    __syncthreads();
}


__device__ __forceinline__ void xpose_tile(const float* src, int ld, int k0, int c0, bf16_t* dst, int ldd, int n0, LAS float* tile) {
    const int tid = tid_opaque(), r = tid >> 3, cc = (tid & 7) * 8;
    f32x4 a = {0.f, 0.f, 0.f, 0.f}, b = {0.f, 0.f, 0.f, 0.f};
    if (c0 >= 0) { const float* s = src + (size_t)(k0 + r) * ld + c0 + cc; a = *(const f32x4*)s; b = *(const f32x4*)(s + 4); }
#pragma unroll
    for (int e = 0; e < 4; ++e) { tile[r * 65 + cc + e] = a[e]; tile[r * 65 + cc + 4 + e] = b[e]; }
    __syncthreads();
    float v[8];
#pragma unroll
    for (int e = 0; e < 8; ++e) v[e] = tile[(cc + e) * 65 + r];
    u32x4 w; w.x = pk2(v[0], v[1]); w.y = pk2(v[2], v[3]); w.z = pk2(v[4], v[5]); w.w = pk2(v[6], v[7]);
    *(u32x4*)(dst + (size_t)(n0 + r) * ldd + k0 + cc) = w;
    __syncthreads();
}

typedef const Params __attribute__((address_space(4)))* KPtr;
__device__ __forceinline__ KPtr kparams() { KPtr k = (KPtr)__builtin_amdgcn_kernarg_segment_ptr(); asm volatile("" : "+s"(k)); return k; }
__device__ __forceinline__ void prep_phase(KPtr pp, LAS unsigned char* lds, int G, int bid) {
    const int tid = tid_opaque(), lane = tid & 63, wid = tid >> 6;
    const int gtid = bid * 512 + tid, gsz = G * 512;
    unsigned char* ws = pp->ws;
    { float* COS = (float*)(ws + OFF_COS); float* SIN = (float*)(ws + OFF_SIN);
      for (int i = gtid; i < T_ALL * 32; i += gsz) {
          const int t = i >> 5, f = i & 31;
          double fr = 1.0; for (int k = 0; k < f; ++k) fr *= 0.7498942093324559;
          const double ang = (double)pp->pos[t] * fr;
          const double kq = __builtin_rint(ang * 0.15915494309189535);
          double r = __builtin_fma(-kq, 6.283185307179586, ang); r = __builtin_fma(-kq, 2.4492935982947064e-16, r);
          const double r2 = r * r; double sn = 1.0, cs = 1.0;
          _Pragma("unroll") for (int k = 15; k >= 1; --k) { sn = 1.0 - sn * r2 * (1.0 / (double)((2 * k) * (2 * k + 1))); cs = 1.0 - cs * r2 * (1.0 / (double)((2 * k - 1) * (2 * k))); }
          COS[i] = (float)cs; SIN[i] = (float)(sn * r);
      } }
    { bf16_t* WSB = (bf16_t*)(ws + OFF_WSB);
      for (int i = gtid; i < 2 * 8 * 128 * 128 / 2; i += gsz) { const int e = i * 2, tt = (e >> 7) & 127, ss = e & 127;
          const float a = ss <= tt ? pp->w_s[e] : 0.f, b = (ss + 1) <= tt ? pp->w_s[e + 1] : 0.f; ((unsigned*)WSB)[i] = pk2(a, b); } }
    { LAS float* tile = (LAS float*)lds;
      const int r = tid >> 3, cc = (tid & 7) * 8;
      for (int tb4 = bid * 4; tb4 < 2 * 4288; tb4 += G * 4) {
          f32x4 va[4], vb[4]; bf16_t* dptr[4];
#pragma unroll
          for (int q = 0; q < 4; ++q) {
              const int ti = tb4 + q; const int l = ti / 4288; int rr = ti - l * 4288; unsigned char* wl = ws + OFF_WL + (size_t)l * WL_STRIDE;
              const float* src; int ld, k0, c0, ldd, n0; bf16_t* dst;
              if (rr < 1664) { const int nb = rr >> 4, kb = rr & 15; n0 = nb * 64; k0 = kb * 64;
                  if (n0 < 4096) c0 = n0; else if (n0 < 6144) c0 = 4544 + (n0 - 4096); else if (n0 < 6400) c0 = 4096 + (n0 - 6144); else if (n0 < 6528) c0 = 4352 + (n0 - 6400); else if (n0 < 6592) c0 = 4480 + (n0 - 6528); else c0 = -1;
                  src = pp->w_in + (size_t)l * 1024 * IN_W; ld = IN_W; dst = (bf16_t*)(wl + WO_W1); ldd = 1024; }
              else if (rr < 1920) { rr -= 1664; const int nb = rr >> 4, kb = rr & 15; n0 = nb * 64; k0 = kb * 64; c0 = n0; src = pp->w_branch + ((size_t)l * 3 + 2) * 1048576; ld = 1024; dst = (bf16_t*)(wl + WO_WBR) + 2 * 1048576; ldd = 1024; }
              else if (rr < 2176) { rr -= 1920; const int nb = rr >> 4, kb = rr & 15; n0 = nb * 64; k0 = kb * 64; c0 = n0; src = pp->w_o + (size_t)l * 1048576; ld = 1024; dst = (bf16_t*)(wl + WO_WO); ldd = 1024; }
              else if (rr < 3584) { rr -= 2176; const int nb = rr >> 4, kb = rr & 15; n0 = nb * 64; k0 = kb * 64; const int uu = n0 >> 8, cc0 = n0 & 255; c0 = (cc0 >> 7) * DFF + 128 * uu + (cc0 & 127);
                  src = pp->w_up + (size_t)l * 1024 * NUP; ld = NUP; dst = (bf16_t*)(wl + WO_WUP); ldd = 1024; }
              else { rr -= 3584; const int nb = rr / 44, kb = rr - nb * 44; n0 = nb * 64; k0 = kb * 64; c0 = n0; src = pp->w_down + (size_t)l * DFF * 1024; ld = 1024; dst = (bf16_t*)(wl + WO_WDN); ldd = DFF; }
              if (c0 >= 0) { const float* s = src + (size_t)(k0 + r) * ld + c0 + cc; va[q] = *(const f32x4*)s; vb[q] = *(const f32x4*)(s + 4); }
              else { va[q] = (f32x4){0.f, 0.f, 0.f, 0.f}; vb[q] = (f32x4){0.f, 0.f, 0.f, 0.f}; }
              dptr[q] = dst + (size_t)(n0 + r) * ldd + k0 + cc;
          }
#pragma unroll
          for (int q = 0; q < 4; ++q)
#pragma unroll
              for (int e = 0; e < 4; ++e) { tile[q * 4160 + r * 65 + cc + e] = va[q][e]; tile[q * 4160 + r * 65 + cc + 4 + e] = vb[q][e]; }
          __syncthreads();
#pragma unroll
          for (int q = 0; q < 4; ++q) { float v[8];
#pragma unroll
              for (int e = 0; e < 8; ++e) v[e] = tile[q * 4160 + (cc + e) * 65 + r];
              u32x4 w; w.x = pk2(v[0], v[1]); w.y = pk2(v[2], v[3]); w.z = pk2(v[4], v[5]); w.w = pk2(v[6], v[7]);
              *(u32x4*)dptr[q] = w; }
          __syncthreads();
      } }
    for (int item = bid * 8 + wid; item < 1024; item += G * 8) { const int l = item >> 9, h = (item >> 6) & 7, jb = (item >> 2) & 15, r = (item & 3) * 64 + lane;
        const float* a = pp->w_uq + ((size_t)(l * 256 + r) * 8 + h) * 192; const float* b = pp->w_ukv + ((size_t)(l * 128 + jb * 8) * 8 + h) * 256; float acc[8];
#pragma unroll
        for (int i = 0; i < 8; ++i) acc[i] = 0.f;
#pragma unroll 4
        for (int d = 0; d < 128; d += 4) { const f32x4 av = *(const f32x4*)(a + d);
#pragma unroll
            for (int i = 0; i < 8; ++i) { const f32x4 bv = *(const f32x4*)(b + (size_t)i * 2048 + d); acc[i] += (av[0] * bv[0] + av[1] * bv[1]) + (av[2] * bv[2] + av[3] * bv[3]); } }
        bf16_t* dq = (bf16_t*)(ws + OFF_WL + (size_t)l * WL_STRIDE + WO_WQ) + (size_t)(h * 128 + jb * 8) * 256 + r;
#pragma unroll
        for (int i = 0; i < 8; ++i) dq[(size_t)i * 256] = (bf16_t)(pk2(acc[i], 0.f) & 0xffffu); }
    for (int i = gtid; i < 2 * 512 * 256; i += gsz) { const int l = i >> 17, n = (i >> 8) & 511, r = i & 255, u2 = n >> 8, cc = n & 255, bj = cc >> 7, h = 4 * u2 + ((cc >> 5) & 3), dd = 128 + (cc & 31) + 32 * bj;
        const float v = pp->w_uq[((size_t)(l * 256 + r) * 8 + h) * 192 + dd];
        ((bf16_t*)(ws + OFF_WL + (size_t)l * WL_STRIDE + WO_WQ))[(size_t)(1024 + n) * 256 + r] = (bf16_t)(pk2(v, 0.f) & 0xffffu); }
    for (int item = bid * 8 + wid; item < 8192; item += G * 8) { const int l = item >> 12, which = (item >> 11) & 1, kk = ((item >> 7) & 15) * 64 + lane, n0 = (item & 127) * 8;
        const float* a; const float* b; const float* sp = nullptr; int K;
        if (which == 1) { const int h = kk >> 7, j = kk & 127; a = pp->w_ukv + ((size_t)(l * 128 + j) * 8 + h) * 256 + 128; b = pp->w_branch + ((size_t)(l * 3 + 1) * 1024 + (size_t)__builtin_amdgcn_readfirstlane(h) * 128) * 1024 + n0; K = 128; }
        else { const int g = __builtin_amdgcn_readfirstlane(kk >> 8), c = kk & 255; a = pp->w_pool + ((size_t)(l * 4 + g) * 256 + c) * 256; sp = pp->s_pool + l * 1024 + g * 256; b = pp->w_branch + ((size_t)(l * 3 + 0) * 1024 + g * 256) * 1024 + n0; K = 256; }
        float acc[8];
#pragma unroll
        for (int i = 0; i < 8; ++i) acc[i] = 0.f;
#pragma unroll 4
        for (int d = 0; d < K; d += 4) { f32x4 av = *(const f32x4*)(a + d); if (sp) av *= *(const f32x4*)(sp + d);
#pragma unroll
            for (int dd = 0; dd < 4; ++dd) { const f32x4 b0 = *(const f32x4*)(b + (size_t)(d + dd) * 1024), b1 = *(const f32x4*)(b + (size_t)(d + dd) * 1024 + 4);
                acc[0] += av[dd] * b0[0]; acc[1] += av[dd] * b0[1]; acc[2] += av[dd] * b0[2]; acc[3] += av[dd] * b0[3]; acc[4] += av[dd] * b1[0]; acc[5] += av[dd] * b1[1]; acc[6] += av[dd] * b1[2]; acc[7] += av[dd] * b1[3]; } }
        bf16_t* dw = (bf16_t*)(ws + OFF_WL + (size_t)l * WL_STRIDE + WO_WBR) + ((size_t)which * 1024 + n0) * 1024 + kk;
#pragma unroll
        for (int i = 0; i < 8; ++i) dw[(size_t)i * 1024] = (bf16_t)(pk2(acc[i], 0.f) & 0xffffu); }
    { LAS float* tab = (LAS float*)lds; LAS float* part = tab + 16384; float* MOD = (float*)(ws + OFF_MOD);
      __syncthreads();
      for (int it = bid; it < 384; it += G) { const int l = it / 192, rem = it - l * 192, nc = rem >> 1, bh = rem & 1;
          for (int i = tid; i < 16384; i += 512) { const int k = i >> 4, bb = i & 15; const float cv = pp->c[(bh * 16 + bb) * 1024 + k]; tab[i] = cv / (1.0f + __expf(-cv)); }
          __syncthreads();
          float acc[16];
#pragma unroll
          for (int b = 0; b < 16; ++b) acc[b] = 0.f;
          const float* wp = pp->w_ada + ((size_t)l * 1024 + wid * 128) * 6144 + nc * 64 + lane;
          _Pragma("unroll 16") for (int k = 0; k < 128; ++k) { const float wv = wp[(size_t)k * 6144]; const LAS f32x4* tp = (const LAS f32x4*)(tab + (wid * 128 + k) * 16);
#pragma unroll
              for (int q = 0; q < 4; ++q) { const f32x4 tv = tp[q]; acc[4 * q] += tv[0] * wv; acc[4 * q + 1] += tv[1] * wv; acc[4 * q + 2] += tv[2] * wv; acc[4 * q + 3] += tv[3] * wv; } }
#pragma unroll
          for (int b = 0; b < 16; ++b) part[(wid * 16 + b) * 64 + lane] = acc[b];
          __syncthreads();
          for (int o = tid; o < 1024; o += 512) { const int bb = o >> 6, nn = o & 63; float s = pp->b_ada[l * 6144 + nc * 64 + nn];
#pragma unroll
              for (int w = 0; w < 8; ++w) s += part[(w * 16 + bb) * 64 + nn];
              MOD[(size_t)(l * 32 + bh * 16 + bb) * 6144 + nc * 64 + nn] = s; }
          __syncthreads();
      } }
}

__device__ __forceinline__ void row_stats(const f32x4 (&v)[4], float& mean, float& rstd) {
    float s = 0.f;
#pragma unroll
    for (int q = 0; q < 4; ++q) s += (v[q][0] + v[q][1]) + (v[q][2] + v[q][3]);
    mean = wave_sum(s) * (1.0f / 1024.0f); float qq = 0.f;
#pragma unroll
    for (int q = 0; q < 4; ++q) { const f32x4 d = v[q] - mean; qq += (d[0] * d[0] + d[1] * d[1]) + (d[2] * d[2] + d[3] * d[3]); }
    rstd = 1.0f / sqrtf(wave_sum(qq) * (1.0f / 1024.0f) + LN_EPS);
}
template <int MODE, bool HOUT>
__device__ __forceinline__ void ln_pass(const float* xin, const bf16_t* yin, const float* gate, float* xout, bf16_t* hout, int tok0, const float* lng, const float* lnb, const float* modsh, const float* modsc, int G, int bid) {
    const int tid = tid_opaque(), lane = tid & 63, wid = tid >> 6;
    const float ALPHA = 1.4142135623730951f;
    constexpr int NR = 4, RPB = SEQ;
    const int nwaves = G * 8, wpb = nwaves / BPS;
    const int gw = bid * 8 + wid, bl = gw / wpb, wi = gw - bl * wpb;
    if (bl >= BPS) return;
    const int b = (tok0 >> 11) + bl;
    f32x4 gv[4], lg[4], lb[4], sc[4], sh[4];
#pragma unroll
    for (int q = 0; q < 4; ++q) {
        if (MODE == 1) { gv[q] = *(const f32x4*)(gate + (size_t)b * 6144 + lane * 4 + q * 256); lg[q] = *(const f32x4*)(lng + lane * 4 + q * 256); lb[q] = *(const f32x4*)(lnb + lane * 4 + q * 256); }
        if (HOUT) { sc[q] = *(const f32x4*)(modsc + (size_t)b * 6144 + lane * 4 + q * 256) + 1.0f; sh[q] = *(const f32x4*)(modsh + (size_t)b * 6144 + lane * 4 + q * 256); } }
    for (int k0 = wi; k0 < RPB; k0 += NR * wpb) {
        f32x4 v[NR][4]; u32x2 yv[NR][4];
#pragma unroll
        for (int u = 0; u < NR; ++u) { const int rl = bl * RPB + k0 + u * wpb;
            const float* xp = xin + ((size_t)tok0 + rl) * 1024 + lane * 4;
#pragma unroll
            for (int q = 0; q < 4; ++q) v[u][q] = *(const f32x4*)(xp + q * 256);
            if (MODE == 1) { const bf16_t* yp = yin + (size_t)rl * 1024 + lane * 4;
#pragma unroll
                for (int q = 0; q < 4; ++q) yv[u][q] = *(const u32x2*)(yp + q * 256); } }
        LOADS_DONE();
#pragma unroll
        for (int u = 0; u < NR; ++u) { const int rl = bl * RPB + k0 + u * wpb;
            if (MODE == 1) {
#pragma unroll
                for (int q = 0; q < 4; ++q) v[u][q] = v[u][q] * ALPHA + gv[q] * (f32x4){bf_lo(yv[u][q].x), bf_hi(yv[u][q].x), bf_lo(yv[u][q].y), bf_hi(yv[u][q].y)}; }
            float mean, rstd; row_stats(v[u], mean, rstd);
            if (MODE == 1) {
                float* op = xout + ((size_t)tok0 + rl) * 1024 + lane * 4;
#pragma unroll
                for (int q = 0; q < 4; ++q) { v[u][q] = (v[u][q] - mean) * rstd * lg[q] + lb[q]; *(f32x4*)(op + q * 256) = v[u][q]; }
                if (HOUT) row_stats(v[u], mean, rstd);
            }
            if (HOUT) {
                bf16_t* hp = hout + (size_t)rl * 1024 + lane * 4;
#pragma unroll
                for (int q = 0; q < 4; ++q) { const f32x4 y = (v[u][q] - mean) * rstd * sc[q] + sh[q]; u32x2 w; w.x = pk2(y[0], y[1]); w.y = pk2(y[2], y[3]); *(u32x2*)(hp + q * 256) = w; }
            }
        }
    }
}

__device__ __forceinline__ void unpack8(const u32x4 w, float (&f)[8]) { f[0] = bf_lo(w.x); f[1] = bf_hi(w.x); f[2] = bf_lo(w.y); f[3] = bf_hi(w.y); f[4] = bf_lo(w.z); f[5] = bf_hi(w.z); f[6] = bf_lo(w.w); f[7] = bf_hi(w.w); }

template <int W>
__device__ __forceinline__ void pool_task(const bf16_t* __restrict__ apool, bf16_t* __restrict__ pooled, int tok0, int ch) {
    constexpr int R = 8, NR = R + W - 1;
    const int s0 = tok0 & (SEQ - 1);
    u32x4 rows[NR];
#pragma unroll
    for (int i = 0; i < NR; ++i) { const int d = i - (W - 1); rows[i] = (s0 + d >= 0) ? *(const u32x4*)(apool + ((size_t)tok0 + d) * 1024 + ch * 8) : (u32x4){0u, 0u, 0u, 0u}; }
    LOADS_DONE();
    float sum[8];
#pragma unroll
    for (int e = 0; e < 8; ++e) sum[e] = 0.f;
#pragma unroll
    for (int i = 0; i < W - 1; ++i) { float t[8]; unpack8(rows[i], t);
#pragma unroll
        for (int e = 0; e < 8; ++e) sum[e] += t[e]; }
#pragma unroll
    for (int r = 0; r < R; ++r) { float cur[8], o[8]; unpack8(rows[r + W - 1], cur);
#pragma unroll
        for (int e = 0; e < 8; ++e) sum[e] += cur[e];
        if (r > 0) { float old[8]; unpack8(rows[r - 1], old);
#pragma unroll
            for (int e = 0; e < 8; ++e) sum[e] -= old[e]; }
        const int cnt = (s0 + r + 1) < W ? (s0 + r + 1) : W; const float inv = 1.0f / (float)cnt;
#pragma unroll
        for (int e = 0; e < 8; ++e) o[e] = sum[e] * inv - cur[e];
        u32x4 wv; wv.x = pk2(o[0], o[1]); wv.y = pk2(o[2], o[3]); wv.z = pk2(o[4], o[5]); wv.w = pk2(o[6], o[7]);
        *(u32x4*)(pooled + ((size_t)tok0 + r) * 1024 + ch * 8) = wv; }
}
__device__ __forceinline__ void pool_pass(const bf16_t* apool, bf16_t* pooled, int G, int bid) {
    const int gtid = bid * 512 + tid_opaque(), gsz = G * 512;
    for (int id = gtid; id < (TS / 8) * 128; id += gsz) {
        const int g = (id >> 6) & 3, ch = g * 32 + (id & 31), run = (id >> 8) * 2 + ((id >> 5) & 1), tok0 = run * 8;
        if (g == 0) pool_task<2>(apool, pooled, tok0, ch); else if (g == 1) pool_task<4>(apool, pooled, tok0, ch); else if (g == 2) pool_task<8>(apool, pooled, tok0, ch); else pool_task<16>(apool, pooled, tok0, ch);
    }
}

__device__ __forceinline__ void norm_pass(const float* raw, bf16_t* cqn, bf16_t* k192, bf16_t* vt, const float* gq, const float* gkv, const float* cosT, const float* sinT, int tok0, LAS unsigned char* lds, int G, int bid) {
    const int tid = tid_opaque(), lane = tid & 63, wid = tid >> 6;
    LAS bf16_t* tl = (LAS bf16_t*)lds;
    const f32x4 gqv = *(const f32x4*)(gq + lane * 4); const float gk0 = gkv[2 * lane], gk1 = gkv[2 * lane + 1];
    for (int it = bid; it < TS / 64; it += G) {
        f32x4 qv[8]; float k0v[8], k1v[8], x1v[8], x2v[8], csv[8], snv[8];
#pragma unroll
        for (int jj = 0; jj < 8; ++jj) { const int tok = it * 64 + wid * 8 + jj; const float* rp = raw + (size_t)tok * 512;
            qv[jj] = *(const f32x4*)(rp + lane * 4); k0v[jj] = rp[256 + 2 * lane]; k1v[jj] = rp[256 + 2 * lane + 1];
            x1v[jj] = rp[384 + (lane & 31)]; x2v[jj] = rp[416 + (lane & 31)]; const size_t tr = (size_t)(tok0 + tok) * 32 + (lane & 31); csv[jj] = cosT[tr]; snv[jj] = sinT[tr]; }
        LOADS_DONE();
#pragma unroll
        for (int jj = 0; jj < 8; ++jj) { const int j = wid * 8 + jj, tok = it * 64 + j; const f32x4 q = qv[jj]; const float k0 = k0v[jj], k1 = k1v[jj];
            const float rq = 1.0f / sqrtf(wave_sum((q[0] * q[0] + q[1] * q[1]) + (q[2] * q[2] + q[3] * q[3])) * (1.0f / 256.0f) + RMS_EPS);
            const float rk = 1.0f / sqrtf(wave_sum(k0 * k0 + k1 * k1) * (1.0f / 128.0f) + RMS_EPS);
            u32x2 w; w.x = pk2(q[0] * rq * gqv[0], q[1] * rq * gqv[1]); w.y = pk2(q[2] * rq * gqv[2], q[3] * rq * gqv[3]); *(u32x2*)(cqn + (size_t)tok * 256 + lane * 4) = w;
            const unsigned kw = pk2(k0 * rk * gk0, k1 * rk * gk1);
            *(unsigned*)(k192 + (size_t)tok * 192 + 2 * lane) = kw; *(LAS unsigned*)(tl + j * 130 + 2 * lane) = kw;
            if (lane < 32) { const float x1 = x1v[jj], x2 = x2v[jj], cs = csv[jj], sn = snv[jj];
                k192[(size_t)tok * 192 + 128 + lane] = (bf16_t)(pk2(x1 * cs - x2 * sn, 0.f) & 0xffffu); k192[(size_t)tok * 192 + 160 + lane] = (bf16_t)(pk2(x2 * cs + x1 * sn, 0.f) & 0xffffu); } }
        __syncthreads();
        { const int d = tid >> 2, part = tid & 3, tokb = it * 64, b = tokb >> 11, s0 = (tokb & (SEQ - 1)) + part * 16; unsigned w[8];
#pragma unroll
          for (int e = 0; e < 8; ++e) { const unsigned lo = tl[(part * 16 + 2 * e) * 130 + d], hi = tl[(part * 16 + 2 * e + 1) * 130 + d]; w[e] = lo | (hi << 16); }
          bf16_t* vp = vt + ((size_t)b * 128 + d) * SEQ + s0;
          *(u32x4*)vp = (u32x4){w[0], w[1], w[2], w[3]}; *(u32x4*)(vp + 8) = (u32x4){w[4], w[5], w[6], w[7]}; }
        __syncthreads();
    }
}

__device__ __forceinline__ void sgu_pass(const bf16_t* uv, bf16_t* outp, const bf16_t* wsb, const float* bs, const float* gsg, const float* bsg, LAS unsigned char* lds, int G, int bid) {
    const int tid = tid_opaque(), lane = tid & 63, wid = tid >> 6, n = lane & 31, hh = lane >> 5;
    LAS unsigned char* vnt = lds;
    LAS float* stats = (LAS float*)(lds + 128 * 272);
    const int ch = tid & 15, half = (tid >> 4) & 1, sb = tid >> 5, s0 = sb * 8 + half * 4;
    const int tb = wid & 3, cb0 = (wid >> 2) * 2, t = tb * 32 + n, nks = 2 * (tb + 1);
    for (int it = bid; it < TS / 128; it += G) {
        const int tokb = it * 128;
#pragma unroll
        for (int hb = 0; hb < 2; ++hb) { u32x4 ra[8], rb[8];
#pragma unroll
            for (int jj = 0; jj < 8; ++jj) { const bf16_t* vp = uv + (size_t)(tokb + wid * 16 + hb * 8 + jj) * 2048 + 1024 + lane * 8; ra[jj] = *(const u32x4*)vp; rb[jj] = *(const u32x4*)(vp + 512); }
            LOADS_DONE();
#pragma unroll
            for (int jj = 0; jj < 8; ++jj) { const int j = wid * 16 + hb * 8 + jj; float a[8], b[8]; unpack8(ra[jj], a); unpack8(rb[jj], b); float s = 0.f;
#pragma unroll
                for (int e = 0; e < 8; ++e) s += a[e] + b[e];
                const float mean = wave_sum(s) * (1.0f / 1024.0f); float qq = 0.f;
#pragma unroll
                for (int e = 0; e < 8; ++e) { const float da = a[e] - mean, db = b[e] - mean; qq += da * da + db * db; }
                const float rstd = 1.0f / sqrtf(wave_sum(qq) * (1.0f / 1024.0f) + LN_EPS);
                if (lane == 0) { stats[2 * j] = mean; stats[2 * j + 1] = rstd; } } }
        u32x4 xr[4];
#pragma unroll
        for (int q = 0; q < 4; ++q) xr[q] = *(const u32x4*)(uv + (size_t)(tokb + s0 + q) * 2048 + 1024 + ch * 8);
        __syncthreads();
        for (int g = 0; g < 8; ++g) {
            { float x[4][8];
#pragma unroll
              for (int q = 0; q < 4; ++q) { unpack8(xr[q], x[q]); const float mu = stats[2 * (s0 + q)], rs = stats[2 * (s0 + q) + 1];
#pragma unroll
                  for (int e = 0; e < 8; ++e) x[q][e] = (x[q][e] - mu) * rs; }
              const f32x4 g0 = *(const f32x4*)(gsg + g * 128 + ch * 8), g1 = *(const f32x4*)(gsg + g * 128 + ch * 8 + 4), b0 = *(const f32x4*)(bsg + g * 128 + ch * 8), b1 = *(const f32x4*)(bsg + g * 128 + ch * 8 + 4);
#pragma unroll
              for (int e = 0; e < 8; ++e) { const float ge = e < 4 ? g0[e & 3] : g1[e & 3], be = e < 4 ? b0[e & 3] : b1[e & 3]; u32x2 w; w.x = pk2(x[0][e] * ge + be, x[1][e] * ge + be); w.y = pk2(x[2][e] * ge + be, x[3][e] * ge + be);
                  *(LAS u32x2*)(vnt + (ch * 8 + e) * 272 + ((sb ^ ch) * 16) + half * 8) = w; } }
            __syncthreads();
            if (g < 7) {
#pragma unroll
                for (int q = 0; q < 4; ++q) xr[q] = *(const u32x4*)(uv + (size_t)(tokb + s0 + q) * 2048 + 1024 + (g + 1) * 128 + ch * 8); }
            { f32x16 acc0, acc1;
#pragma unroll
              for (int i = 0; i < 16; ++i) { acc0[i] = 0.f; acc1[i] = 0.f; }
              const size_t tok = (size_t)(tokb + t); u32x2 uw[2][4];
#pragma unroll
              for (int cbi = 0; cbi < 2; ++cbi)
#pragma unroll
                  for (int gq = 0; gq < 4; ++gq) uw[cbi][gq] = *(const u32x2*)(uv + tok * 2048 + g * 128 + (cb0 + cbi) * 32 + 8 * gq + 4 * hh);
              const float bsv = bs[t * 8 + g];
              const bf16_t* wp = wsb + ((size_t)g * 128 + t) * 128 + 8 * hh; const int c0 = cb0 * 32 + n, c1 = c0 + 32;
              bf16x8 bfr[8];
#pragma unroll
              for (int ks = 0; ks < 8; ++ks) bfr[ks] = (ks < nks) ? *(const bf16x8*)(wp + 16 * ks) : (bf16x8){0, 0, 0, 0, 0, 0, 0, 0};
              LOADS_DONE();
#pragma unroll
              for (int ks = 0; ks < 8; ++ks) if (ks < nks) {
                  const bf16x8 a0 = *(const LAS bf16x8*)(vnt + c0 * 272 + (((2 * ks + hh) ^ (c0 >> 3)) * 16)), a1 = *(const LAS bf16x8*)(vnt + c1 * 272 + (((2 * ks + hh) ^ (c1 >> 3)) * 16));
                  acc0 = __builtin_amdgcn_mfma_f32_32x32x16_bf16(a0, bfr[ks], acc0, 0, 0, 0); acc1 = __builtin_amdgcn_mfma_f32_32x32x16_bf16(a1, bfr[ks], acc1, 0, 0, 0); }
#pragma unroll
              for (int cbi = 0; cbi < 2; ++cbi)
#pragma unroll
                  for (int gq = 0; gq < 4; ++gq) { const int cc = g * 128 + (cb0 + cbi) * 32 + 8 * gq + 4 * hh; const u32x2 u2 = uw[cbi][gq];
                      const float z0 = (cbi ? acc1[4 * gq] : acc0[4 * gq]) + bsv, z1 = (cbi ? acc1[4 * gq + 1] : acc0[4 * gq + 1]) + bsv, z2 = (cbi ? acc1[4 * gq + 2] : acc0[4 * gq + 2]) + bsv, z3 = (cbi ? acc1[4 * gq + 3] : acc0[4 * gq + 3]) + bsv;
                      u32x2 w; w.x = pk2(bf_lo(u2.x) * z0, bf_hi(u2.x) * z1); w.y = pk2(bf_lo(u2.y) * z2, bf_hi(u2.y) * z3); *(u32x2*)(outp + tok * 1024 + cc) = w; } }
            __syncthreads();
        }
    }
}

constexpr int AT_KSTR = 400, AT_VSTR = 136, AT_KBYTES = 64 * AT_KSTR, AT_VBYTES = 128 * AT_VSTR, AT_STAGE = AT_KBYTES + AT_VBYTES;
__device__ __forceinline__ void attn_phase(LAS unsigned char* lds, const bf16_t* QP, const bf16_t* K192, const bf16_t* VT, bf16_t* CTX, int G, int bid) {
    const int tid = tid_opaque(), lane = tid & 63, wid = __builtin_amdgcn_readfirstlane(tid >> 6), n = lane & 31, hh = lane >> 5;
    constexpr int NITEMS = BPS * 32 * 2;
    for (int rnd = 0; rnd * G < NITEMS; ++rnd) {
        const int j = rnd * G + ((rnd & 1) ? (G - 1 - bid) : bid);
        if (j >= NITEMS) continue;
        const int c = 31 - (j >> 5), sub = j & 31, b = sub >> 1, hq = sub & 1;
        const int h = hq * 4 + (wid & 3), qs = wid >> 2;
        const size_t tq = (size_t)b * SEQ + c * 64 + qs * 32 + n;
        bf16x8 qf[12];
        { const bf16_t* qptr = QP + tq * NQ + h * 192 + 8 * hh;
#pragma unroll
          for (int ks = 0; ks < 12; ++ks) qf[ks] = *(const bf16x8*)(qptr + 16 * ks); }
        f32x16 o[4];
#pragma unroll
        for (int db = 0; db < 4; ++db)
#pragma unroll
            for (int i = 0; i < 16; ++i) o[db][i] = 0.f;
        float m_run = -__builtin_inff(), l_run = 0.f;
        const bf16_t* kbase = K192 + (size_t)b * SEQ * 192; const bf16_t* vbase = VT + (size_t)b * 128 * SEQ;
        u32x4 kr[3], vr[2];
#define AT_LOAD(kt) do { _Pragma("unroll") for (int i = 0; i < 3; ++i) { const int id = tid + 512 * i, row = id / 24, cc = id - row * 24; kr[i] = *(const u32x4*)(kbase + (size_t)((kt) * 64 + row) * 192 + cc * 8); } \
        _Pragma("unroll") for (int i = 0; i < 2; ++i) { const int id = tid + 512 * i, d = id >> 3, cc = id & 7; vr[i] = *(const u32x4*)(vbase + (size_t)d * SEQ + (kt) * 64 + cc * 8); } } while (0)
#define AT_STORE(buf) do { LAS unsigned char* sb_ = lds + (buf) * AT_STAGE; _Pragma("unroll") for (int i = 0; i < 3; ++i) { const int id = tid + 512 * i, row = id / 24, cc = id - row * 24; *(LAS u32x4*)(sb_ + row * AT_KSTR + cc * 16) = kr[i]; } \
        _Pragma("unroll") for (int i = 0; i < 2; ++i) { const int id = tid + 512 * i, d = id >> 3, cc = id & 7; LAS unsigned char* vp_ = sb_ + AT_KBYTES + d * AT_VSTR + cc * 16; *(LAS u32x2*)vp_ = (u32x2){vr[i].x, vr[i].y}; *(LAS u32x2*)(vp_ + 8) = (u32x2){vr[i].z, vr[i].w}; } } while (0)
        AT_LOAD(0); AT_STORE(0);
        __syncthreads();
        for (int kt = 0; kt <= c; ++kt) {
            if (kt < c) AT_LOAD(kt + 1);
            LOADS_DONE();
            const LAS unsigned char* Ks = lds + (kt & 1) * AT_STAGE; const LAS unsigned char* Vs = Ks + AT_KBYTES;
            f32x16 s0, s1;
#pragma unroll
            for (int i = 0; i < 16; ++i) { s0[i] = 0.f; s1[i] = 0.f; }
            { const LAS unsigned char* ka = Ks + n * AT_KSTR + hh * 16;
#pragma unroll
              for (int ks = 0; ks < 12; ++ks) { const bf16x8 a0 = *(const LAS bf16x8*)(ka + ks * 32), a1 = *(const LAS bf16x8*)(ka + 32 * AT_KSTR + ks * 32);
                  s0 = __builtin_amdgcn_mfma_f32_32x32x16_bf16(a0, qf[ks], s0, 0, 0, 0); s1 = __builtin_amdgcn_mfma_f32_32x32x16_bf16(a1, qf[ks], s1, 0, 0, 0); } }
            float mx = s0[0];
#pragma unroll
            for (int i = 1; i < 16; ++i) mx = fmaxf(mx, s0[i]);
#pragma unroll
            for (int i = 0; i < 16; ++i) mx = fmaxf(mx, s1[i]);
            mx = fmaxf(mx, __shfl_xor(mx, 32));
            const float m_new = fmaxf(m_run, mx), alpha = __builtin_amdgcn_exp2f(m_run - m_new); m_run = m_new;
            float rs = 0.f;
#pragma unroll
            for (int i = 0; i < 16; ++i) { s0[i] = __builtin_amdgcn_exp2f(s0[i] - m_new); s1[i] = __builtin_amdgcn_exp2f(s1[i] - m_new); rs += s0[i] + s1[i]; }
            rs += __shfl_xor(rs, 32); l_run = l_run * alpha + rs;
#pragma unroll
            for (int db = 0; db < 4; ++db) o[db] *= alpha;
#pragma unroll
            for (int mb = 0; mb < 2; ++mb)
#pragma unroll
                for (int jj = 0; jj < 2; ++jj) {
                    u32x4 pw;
                    if (mb == 0) { pw.x = pk2(s0[8 * jj], s0[8 * jj + 1]); pw.y = pk2(s0[8 * jj + 2], s0[8 * jj + 3]); pw.z = pk2(s0[8 * jj + 4], s0[8 * jj + 5]); pw.w = pk2(s0[8 * jj + 6], s0[8 * jj + 7]); }
                    else { pw.x = pk2(s1[8 * jj], s1[8 * jj + 1]); pw.y = pk2(s1[8 * jj + 2], s1[8 * jj + 3]); pw.z = pk2(s1[8 * jj + 4], s1[8 * jj + 5]); pw.w = pk2(s1[8 * jj + 6], s1[8 * jj + 7]); }
                    const bf16x8 pf = __builtin_bit_cast(bf16x8, pw);
                    const LAS unsigned char* va = Vs + n * AT_VSTR + (mb * 32 + 16 * jj + 4 * hh) * 2;
#pragma unroll
                    for (int db = 0; db < 4; ++db) { const s16x4 lo = *(const LAS s16x4*)(va + db * 32 * AT_VSTR), hi = *(const LAS s16x4*)(va + db * 32 * AT_VSTR + 16);
                        const bf16x8 vf = __builtin_shufflevector(lo, hi, 0, 1, 2, 3, 4, 5, 6, 7);
                        o[db] = __builtin_amdgcn_mfma_f32_32x32x16_bf16(vf, pf, o[db], 0, 0, 0); }
                }
            if (kt < c) AT_STORE((kt + 1) & 1);
            __syncthreads();
        }
#undef AT_LOAD
#undef AT_STORE
        { const float inv = 1.0f / l_run; bf16_t* optr = CTX + tq * 1024 + h * 128 + 4 * hh;
#pragma unroll
          for (int db = 0; db < 4; ++db)
#pragma unroll
              for (int gq = 0; gq < 4; ++gq) { u32x2 w; w.x = pk2(o[db][4 * gq] * inv, o[db][4 * gq + 1] * inv); w.y = pk2(o[db][4 * gq + 2] * inv, o[db][4 * gq + 3] * inv); *(u32x2*)(optr + db * 32 + 8 * gq) = w; } }
    }
}

__device__ __forceinline__ void conv_pass(const bf16_t* __restrict__ z, bf16_t* __restrict__ ff, const float* __restrict__ cw, const float* __restrict__ cb, int G, int bid) {
    const int gtid = bid * 512 + tid_opaque(), gsz = G * 512;
    constexpr int RUN = 8, NTASK = (TS / RUN) * 352;
    for (int id = gtid; id < NTASK; id += gsz) {
        const int run = id / 352, ch = id - run * 352, uu = ch >> 4, j0 = (ch & 15) * 8, colv = 128 * uu + j0, colg = DFF + colv, tok0 = run * RUN, s0 = tok0 & (SEQ - 1);
        const bf16_t* zp = z + (size_t)tok0 * NUP + 256 * uu + j0;
        u32x4 zv[RUN + 2], zg[RUN + 2];
#pragma unroll
        for (int i = 0; i < RUN + 2; ++i) { const int d = i - 2;
            if (s0 + d >= 0) { zv[i] = *(const u32x4*)(zp + (ptrdiff_t)d * NUP); zg[i] = *(const u32x4*)(zp + (ptrdiff_t)d * NUP + 128); } else { zv[i] = (u32x4){0u, 0u, 0u, 0u}; zg[i] = (u32x4){0u, 0u, 0u, 0u}; } }
        float wv[3][8], wg[3][8], bv[8], bg[8];
#pragma unroll
        for (int k = 0; k < 3; ++k) { const f32x4 a = *(const f32x4*)(cw + k * NUP + colv), b = *(const f32x4*)(cw + k * NUP + colv + 4), c = *(const f32x4*)(cw + k * NUP + colg), d = *(const f32x4*)(cw + k * NUP + colg + 4);
#pragma unroll
            for (int e = 0; e < 4; ++e) { wv[k][e] = a[e]; wv[k][4 + e] = b[e]; wg[k][e] = c[e]; wg[k][4 + e] = d[e]; } }
        { const f32x4 a = *(const f32x4*)(cb + colv), b = *(const f32x4*)(cb + colv + 4), c = *(const f32x4*)(cb + colg), d = *(const f32x4*)(cb + colg + 4);
#pragma unroll
          for (int e = 0; e < 4; ++e) { bv[e] = a[e]; bv[4 + e] = b[e]; bg[e] = c[e]; bg[4 + e] = d[e]; } }
        LOADS_DONE();
        float v2[8], v1[8], g2[8], g1[8];
        unpack8(zv[0], v2); unpack8(zv[1], v1); unpack8(zg[0], g2); unpack8(zg[1], g1);
#pragma unroll
        for (int r = 0; r < RUN; ++r) { float v0[8], g0[8], o[8]; unpack8(zv[r + 2], v0); unpack8(zg[r + 2], g0);
#pragma unroll
            for (int e = 0; e < 8; ++e) { const float vc = bv[e] + wv[0][e] * v2[e] + wv[1][e] * v1[e] + wv[2][e] * v0[e], gc = bg[e] + wg[0][e] * g2[e] + wg[1][e] * g1[e] + wg[2][e] * g0[e];
                o[e] = gc * pg8::sigm(gc) * vc; v2[e] = v1[e]; v1[e] = v0[e]; g2[e] = g1[e]; g1[e] = g0[e]; }
            u32x4 w; w.x = pk2(o[0], o[1]); w.y = pk2(o[2], o[3]); w.z = pk2(o[4], o[5]); w.w = pk2(o[6], o[7]);
            *(u32x4*)(ff + (size_t)(tok0 + r) * DFF + colv) = w; }
    }
}

__device__ __forceinline__ void conv_fix(const float* __restrict__ zb, bf16_t* __restrict__ ff, const float* __restrict__ cw, const float* __restrict__ cb, int G, int bid) {
    const int gtid = bid * 512 + tid_opaque(), gsz = G * 512;
    for (int id = gtid; id < (TS / 64) * 352; id += gsz) {
        const int gi = id / 352, ch = id - gi * 352, uu = ch >> 4, j0 = (ch & 15) * 8, colv = 128 * uu + j0, colg = DFF + colv, zc = 256 * uu + j0;
        const bool hasprev = (gi & 31) != 0;
        float zv[4][8], zg[4][8];
#pragma unroll
        for (int r = 0; r < 4; ++r) {
            const float* zp = zb + ((size_t)(r < 2 ? gi - 1 : gi) * 4 + (r < 2 ? 2 + r : r - 2)) * NUP + zc;
            if (r >= 2 || hasprev) { const f32x4 a = *(const f32x4*)zp, b = *(const f32x4*)(zp + 4), c = *(const f32x4*)(zp + 128), d = *(const f32x4*)(zp + 132);
#pragma unroll
                for (int e = 0; e < 4; ++e) { zv[r][e] = a[e]; zv[r][4 + e] = b[e]; zg[r][e] = c[e]; zg[r][4 + e] = d[e]; } }
            else {
#pragma unroll
                for (int e = 0; e < 8; ++e) { zv[r][e] = 0.f; zg[r][e] = 0.f; } } }
        float wv[3][8], wg[3][8], bv[8], bg[8];
#pragma unroll
        for (int k = 0; k < 3; ++k) { const f32x4 a = *(const f32x4*)(cw + k * NUP + colv), b = *(const f32x4*)(cw + k * NUP + colv + 4), c = *(const f32x4*)(cw + k * NUP + colg), d = *(const f32x4*)(cw + k * NUP + colg + 4);
#pragma unroll
            for (int e = 0; e < 4; ++e) { wv[k][e] = a[e]; wv[k][4 + e] = b[e]; wg[k][e] = c[e]; wg[k][4 + e] = d[e]; } }
        { const f32x4 a = *(const f32x4*)(cb + colv), b = *(const f32x4*)(cb + colv + 4), c = *(const f32x4*)(cb + colg), d = *(const f32x4*)(cb + colg + 4);
#pragma unroll
          for (int e = 0; e < 4; ++e) { bv[e] = a[e]; bv[4 + e] = b[e]; bg[e] = c[e]; bg[4 + e] = d[e]; } }
        LOADS_DONE();
#pragma unroll
        for (int r = 0; r < 2; ++r) { float o[8];
#pragma unroll
            for (int e = 0; e < 8; ++e) { const float vc = bv[e] + wv[0][e] * zv[r][e] + wv[1][e] * zv[r + 1][e] + wv[2][e] * zv[r + 2][e], gc = bg[e] + wg[0][e] * zg[r][e] + wg[1][e] * zg[r + 1][e] + wg[2][e] * zg[r + 2][e];
                o[e] = gc * pg8::sigm(gc) * vc; }
            u32x4 w; w.x = pk2(o[0], o[1]); w.y = pk2(o[2], o[3]); w.z = pk2(o[4], o[5]); w.w = pk2(o[6], o[7]);
            *(u32x4*)(ff + (size_t)(gi * 64 + r) * DFF + colv) = w; }
    }
}

__global__ void __launch_bounds__(512, 2) mega_fwd(Params p_unused) {
    extern __shared__ __attribute__((aligned(16))) unsigned char lds_raw[];
    LAS unsigned char* lds = (LAS unsigned char*)lds_raw;
    cg::grid_group grid = cg::this_grid();
    (void)p_unused;
    if (threadIdx.x < 2) ((LAS unsigned*)(lds + LDS_BARST))[threadIdx.x] = 0u;
    __syncthreads();
    { KPtr p0 = kparams(); (void)xcd_barrier_post((unsigned*)(p0->ws + OFF_BAR), (volatile LAS unsigned*)(lds + LDS_BARST)); }
#define GSYNC() do { KPtr pb_ = kparams(); XcdBarrier xb_; xb_.bar = (unsigned*)(pb_->ws + OFF_BAR); xb_.x = xb_xcc_id(); xb_.st = (volatile LAS unsigned*)(lds + LDS_BARST); xcd_barrier(xb_); } while (0)
#ifdef PROBE_MASK
    unsigned long long t_prev = __builtin_amdgcn_s_memrealtime(), t_acc = 0ull;
#define STAMP(cls) do { const unsigned long long t_ = __builtin_amdgcn_s_memrealtime(); if ((PROBE_MASK >> (cls)) & 1) t_acc += t_ - t_prev; t_prev = t_; } while (0)
#else
#define STAMP(cls) do { } while (0)
#endif
#define PH_BEGIN KPtr p = kparams(); int G = (int)gridDim.x, bid = (int)blockIdx.x; asm volatile("" : "+s"(G), "+s"(bid)); unsigned char* ws = p->ws; (void)ws;
    { PH_BEGIN prep_phase(p, lds, G, bid); }
    grid.sync(); STAMP(0);
    for (int sl = 0; sl < NS; ++sl) {
        const int tok0 = sl * TS;
        { PH_BEGIN const float* MOD = (const float*)(ws + OFF_MOD);
          ln_pass<0, true>(p->x, nullptr, nullptr, nullptr, (bf16_t*)(ws + OFF_H), tok0, nullptr, nullptr, MOD + 0, MOD + 1024, G, bid); }
        GSYNC(); STAMP(7);
        for (int l = 0; l < 2; ++l) {
            { PH_BEGIN const unsigned char* wl = ws + OFF_WL + (size_t)l * WL_STRIDE;
              pg8::Gemm g{(const bf16_t*)(ws + OFF_H), (const bf16_t*)(wl + WO_W1), TS, N1, 1024}; pg8::StaticOrder S; S.init(TS, N1, G, bid);
              pg8::Epi1 E{(bf16_t*)(ws + OFF_GATES), (bf16_t*)(ws + OFF_APOOL), (bf16_t*)(ws + OFF_UV), (float*)(ws + OFF_RAW)};
              pg8::gemm_phase<pg8::Epi1, pg8::StaticOrder, true, true>(lds, g, S, E); }
            GSYNC(); STAMP(1);
            { PH_BEGIN pool_pass((const bf16_t*)(ws + OFF_APOOL), (bf16_t*)(ws + OFF_BR), G, bid); }
            { PH_BEGIN
              norm_pass((const float*)(ws + OFF_RAW), (bf16_t*)(ws + OFF_CQN), (bf16_t*)(ws + OFF_K192), (bf16_t*)(ws + OFF_VT), p->g_q + l * 256, p->g_kv + l * 128, (const float*)(ws + OFF_COS), (const float*)(ws + OFF_SIN), tok0, lds, G, bid); }
            { PH_BEGIN
              sgu_pass((const bf16_t*)(ws + OFF_UV), (bf16_t*)(ws + OFF_BR) + (size_t)2 * TS * 1024, (const bf16_t*)(ws + OFF_WSB) + (size_t)l * 8 * 128 * 128, p->b_s + l * 1024, p->g_sg + l * 1024, p->b_sg + l * 1024, lds, G, bid); }
            GSYNC(); STAMP(2);
            { PH_BEGIN const unsigned char* wl = ws + OFF_WL + (size_t)l * WL_STRIDE;
              int kq = 256; asm volatile("" : "+s"(kq));
              pg8::Gemm g{(const bf16_t*)(ws + OFF_CQN), (const bf16_t*)(wl + WO_WQ), TS, NQ, kq}; pg8::StaticOrder S; S.init(TS, NQ, G, bid);
              pg8::EpiQ E{(bf16_t*)(ws + OFF_QP), (const float*)(ws + OFF_COS), (const float*)(ws + OFF_SIN), tok0};
              pg8::gemm_phase<pg8::EpiQ, pg8::StaticOrder, true, true>(lds, g, S, E); }
            GSYNC(); STAMP(3);
            { PH_BEGIN
              attn_phase(lds, (const bf16_t*)(ws + OFF_QP), (const bf16_t*)(ws + OFF_K192), (const bf16_t*)(ws + OFF_VT), (bf16_t*)(ws + OFF_BR) + (size_t)TS * 1024, G, bid); }
            GSYNC(); STAMP(4);
            { PH_BEGIN const unsigned char* wl = ws + OFF_WL + (size_t)l * WL_STRIDE;
              pg8::Gemm g{(const bf16_t*)(ws + OFF_BR), (const bf16_t*)(wl + WO_WBR), 3 * TS, 3 * 1024, 1024}; pg8::BrOrder S; S.init(TS, G, bid);
              pg8::EpiBr E{(const bf16_t*)(ws + OFF_GATES), (float*)(ws + OFF_PART), (bf16_t*)(ws + OFF_H), TS / 256};
              pg8::gemm_phase<pg8::EpiBr, pg8::BrOrder, true, true>(lds, g, S, E); }
            GSYNC(); STAMP(5);
            { PH_BEGIN const unsigned char* wl = ws + OFF_WL + (size_t)l * WL_STRIDE;
              pg8::Gemm g{(const bf16_t*)(ws + OFF_H), (const bf16_t*)(wl + WO_WO), TS, 1024, 1024}; pg8::StaticOrder S; S.init(TS, 1024, G, bid);
              pg8::EpiUp E{(bf16_t*)(ws + OFF_Y), 1024};
              pg8::gemm_phase<pg8::EpiUp, pg8::StaticOrder, true, true>(lds, g, S, E); }
            GSYNC(); STAMP(6);
            { PH_BEGIN const float* modl = (const float*)(ws + OFF_MOD) + (size_t)l * 32 * 6144;
              ln_pass<1, true>((l == 0) ? p->x : (const float*)p->out, (const bf16_t*)(ws + OFF_Y), modl + 2048, p->out, (bf16_t*)(ws + OFF_H), tok0, p->ln_t_g + l * 1024, p->ln_t_b + l * 1024, modl + 3072, modl + 4096, G, bid); }
            GSYNC(); STAMP(7);
            { PH_BEGIN const unsigned char* wl = ws + OFF_WL + (size_t)l * WL_STRIDE;
              pg8::Gemm g{(const bf16_t*)(ws + OFF_H), (const bf16_t*)(wl + WO_WUP), TS, NUP, 1024}; pg8::StaticOrder S; S.init(TS, NUP, G, bid); pg8::EpiUp E{(bf16_t*)(ws + OFF_Z), NUP};
              pg8::gemm_phase<pg8::EpiUp, pg8::StaticOrder, true, true>(lds, g, S, E); }
            GSYNC(); STAMP(8);
            { PH_BEGIN conv_pass((const bf16_t*)(ws + OFF_Z), (bf16_t*)(ws + OFF_FF), p->conv_w + (size_t)l * 3 * NUP, p->conv_b + (size_t)l * NUP, G, bid); }
            GSYNC(); STAMP(9);
            { PH_BEGIN const unsigned char* wl = ws + OFF_WL + (size_t)l * WL_STRIDE;
              pg8::Gemm g{(const bf16_t*)(ws + OFF_FF), (const bf16_t*)(wl + WO_WDN), TS, 1024, DFF}; pg8::StaticOrder S; S.init(TS, 1024, G, bid); pg8::EpiUp E{(bf16_t*)(ws + OFF_Y), 1024};
              pg8::gemm_phase<pg8::EpiUp, pg8::StaticOrder, true, true>(lds, g, S, E); }
            GSYNC(); STAMP(10);
            { PH_BEGIN const float* modl = (const float*)(ws + OFF_MOD) + (size_t)l * 32 * 6144; const float* mod1 = (const float*)(ws + OFF_MOD) + (size_t)32 * 6144;
              if (l == 0) ln_pass<1, true>(p->out, (const bf16_t*)(ws + OFF_Y), modl + 5120, p->out, (bf16_t*)(ws + OFF_H), tok0, p->ln_f_g, p->ln_f_b, mod1, mod1 + 1024, G, bid);
              else ln_pass<1, false>(p->out, (const bf16_t*)(ws + OFF_Y), modl + 5120, p->out, nullptr, tok0, p->ln_f_g + 1024, p->ln_f_b + 1024, nullptr, nullptr, G, bid); }
            GSYNC(); STAMP(7);
        }
    }
#ifdef PROBE_MASK
    { PH_BEGIN (void)G; if (bid == 0) { unsigned long long us = t_acc / 100ull; if (us > 20000ull) us = 20000ull; for (int i = tid_opaque(); i < (int)us; i += 512) p->out[i] += 0.1f; } }
#endif
}

extern "C" void kernel_launch(void* const* d_in, const int* in_sizes, int n_in, void* d_out, int out_size, void* d_ws, size_t ws_size, hipStream_t stream) {
    static int grid = 0;
    if (grid == 0) {
        if (n_in != 26 || ws_size < WS_NEED) { fprintf(stderr, "kernel_launch: unexpected n_in %d / ws_size %zu\n", n_in, ws_size); grid = -1; return; }
        int dev = 0, cus = 0, per_cu = 0;
        if (hipGetDevice(&dev) != hipSuccess || hipDeviceGetAttribute(&cus, hipDeviceAttributeMultiprocessorCount, dev) != hipSuccess) { grid = -1; return; }
        if (hipFuncSetAttribute((const void*)mega_fwd, hipFuncAttributeMaxDynamicSharedMemorySize, LDS_BYTES) != hipSuccess) { fprintf(stderr, "kernel_launch: hipFuncSetAttribute failed\n"); grid = -1; return; }
        if (hipOccupancyMaxActiveBlocksPerMultiprocessor(&per_cu, (const void*)mega_fwd, 512, LDS_BYTES) != hipSuccess || per_cu < 1) { fprintf(stderr, "kernel_launch: occupancy query says %d\n", per_cu); per_cu = 1; }
        (void)hipGetLastError();
        grid = cus;
    }
    if (grid < 0) return;
    Params p{};
    const float** pf = (const float**)&p;
    p.x = (const float*)d_in[0]; p.c = (const float*)d_in[1]; p.pos = (const int*)d_in[2]; p.w_ada = (const float*)d_in[3]; p.b_ada = (const float*)d_in[4]; p.w_in = (const float*)d_in[5];
    p.w_pool = (const float*)d_in[6]; p.s_pool = (const float*)d_in[7]; p.g_q = (const float*)d_in[8]; p.w_uq = (const float*)d_in[9]; p.g_kv = (const float*)d_in[10]; p.w_ukv = (const float*)d_in[11];
    p.g_sg = (const float*)d_in[12]; p.b_sg = (const float*)d_in[13]; p.w_s = (const float*)d_in[14]; p.b_s = (const float*)d_in[15]; p.w_branch = (const float*)d_in[16]; p.w_o = (const float*)d_in[17];
    p.ln_t_g = (const float*)d_in[18]; p.ln_t_b = (const float*)d_in[19]; p.w_up = (const float*)d_in[20]; p.conv_w = (const float*)d_in[21]; p.conv_b = (const float*)d_in[22]; p.w_down = (const float*)d_in[23];
    p.ln_f_g = (const float*)d_in[24]; p.ln_f_b = (const float*)d_in[25];
    (void)pf;
    p.out = (float*)d_out; p.ws = (unsigned char*)d_ws;
    if (hipMemsetAsync((unsigned char*)d_ws + OFF_BAR, 0, BAR_BYTES, stream) != hipSuccess) { fprintf(stderr, "kernel_launch: memset failed\n"); return; }
    void* args[] = {&p};
    const hipError_t e = hipLaunchCooperativeKernel((const void*)mega_fwd, dim3(grid), dim3(512), args, LDS_BYTES, stream);
    if (e != hipSuccess) fprintf(stderr, "kernel_launch: cooperative launch failed: %s (grid %d)\n", hipGetErrorString(e), grid);
}
```

```cpp
#include <hip/hip_runtime.h>
#include <hip/hip_cooperative_groups.h>
#include <cstdio>
#include <cstdint>
namespace cg = cooperative_groups;
namespace pg8 {
#define PG8_LAS __attribute__((address_space(3)))
typedef unsigned short bf16_t;
typedef short bf16x8 __attribute__((ext_vector_type(8)));
typedef float f32x4 __attribute__((ext_vector_type(4)));
typedef unsigned u32x4 __attribute__((ext_vector_type(4)));
constexpr int BM = 256, BK = 64, HALF = 128, HTB = HALF * BK * 2  , STAGE_BYTES = 8 * HTB, NXCD = 8, WGM = 8;

__host__ __device__ __forceinline__ int lds_byte(int r, int c) { const int st = (r >> 4) * 2 + (c >> 5), rr = r & 15, cc = c & 31, ob = rr * 64 + cc * 2; return st * 1024 + (ob ^ (((ob >> 9) & 1) << 5)); }
__host__ __device__ __forceinline__ void stage_rc(int b, int& R, int& C) { const int st = b / 1024, sb = b % 1024, swz = sb ^ (((sb >> 9) & 1) << 5); R = (st >> 1) * 16 + swz / 64; C = (st & 1) * 32 + (swz % 64) / 2; }
__host__ __device__ __forceinline__ int perm32(int rho) { const int n = rho >> 4, i = rho & 15; return 8 * (i >> 2) + 4 * n + (i & 3); }

struct Unit { int pm, pn; };
struct Gemm { const bf16_t* A; const bf16_t* Bt; int M, N, K; };

struct StaticOrder {
    int nM, nN, nwg, G, c;
    __host__ __device__ void init(int M, int N, int G_, int c_) { nM = M / BM; nN = N / BM; nwg = nM * nN; G = G_; c = c_; }
    __host__ __device__ bool next(int i, Unit& u) const {
        const long L = (long)i * G + c; if (L >= nwg) return false;
        int wgid = (int)L; { const int q = nwg / NXCD, r = nwg % NXCD, xcd = wgid % NXCD, off = wgid / NXCD; wgid = (xcd < r ? xcd * (q + 1) : r * (q + 1) + (xcd - r) * q) + off; }
        const int nig = WGM * nN, gid = wgid / nig, fm = gid * WGM, gsz = (nM - fm) < WGM ? (nM - fm) : WGM;
        u.pm = fm + ((wgid % nig) % gsz); u.pn = (wgid % nig) / gsz; return true;
    }
    __device__ __forceinline__ void a_ready(const Unit&) const {}
    __device__ __forceinline__ void done(const Unit&) const {}
};


typedef float f32x2 __attribute__((ext_vector_type(2)));
typedef __bf16 bfv2 __attribute__((ext_vector_type(2)));
typedef unsigned u32x2 __attribute__((ext_vector_type(2)));
__device__ __forceinline__ unsigned pk2(float a, float b) { f32x2 v = {a, b}; bfv2 r = __builtin_convertvector(v, bfv2); return __builtin_bit_cast(unsigned, r); }
__device__ __forceinline__ float bf_lo(unsigned w) { return __uint_as_float(w << 16); }
__device__ __forceinline__ float bf_hi(unsigned w) { return __uint_as_float(w & 0xffff0000u); }
__device__ __forceinline__ u32x4 pack8(const f32x4 a, const f32x4 b) { u32x4 w; w.x = pk2(a[0], a[1]); w.y = pk2(a[2], a[3]); w.z = pk2(b[0], b[1]); w.w = pk2(b[2], b[3]); return w; }
__device__ __forceinline__ f32x2 gelu_pk(f32x2 v) {
    const f32x2 av = __builtin_elementwise_abs(v), d = av * 0.2316418882f + 1.0f;
    f32x2 t; t.x = __builtin_amdgcn_rcpf(d.x); t.y = __builtin_amdgcn_rcpf(d.y);
    f32x2 q = t * 0.5307027145f + (-0.7265760135f); q = q * t + 0.7107068705f; q = q * t + (-0.142248368f); q = q * t + 0.127414796f; q = q * t;
    const f32x2 s = (v * v) * (-0.72134752044f);
    f32x2 e; e.x = __builtin_amdgcn_exp2f(s.x); e.y = __builtin_amdgcn_exp2f(s.y);
    const f32x2 m = v * (q * e), r = v - m;
    f32x2 o; o.x = v.x < 0.f ? m.x : r.x; o.y = v.y < 0.f ? m.y : r.y; return o;
}
__device__ __forceinline__ f32x4 gelu4(f32x4 v) { const f32x2 a = gelu_pk((f32x2){v[0], v[1]}), b = gelu_pk((f32x2){v[2], v[3]}); return (f32x4){a.x, a.y, b.x, b.y}; }
__device__ __forceinline__ float sigm(float x) { return __builtin_amdgcn_rcpf(1.0f + __builtin_amdgcn_exp2f(-1.4426950408889634f * x)); }
__device__ __forceinline__ f32x4 sigm4(f32x4 v) { return (f32x4){sigm(v[0]), sigm(v[1]), sigm(v[2]), sigm(v[3])}; }

struct Epi1 {
    static constexpr bool PERM = true, AFTER_DRAIN = false;
    bf16_t* gates; bf16_t* apool; bf16_t* uv; float* raw;
    __device__ __forceinline__ void operator()(const f32x4 (&acc)[2][2][4][2], const Unit& u, int wr, int wc, int fr, int fq) const {
        const int row0 = u.pm * BM + wr * 64 + fr, cl = wc * 32 + 8 * fq, pn = u.pn;
        if (pn < 24) {
            bf16_t* base; int ldc, col0, act;
            if (pn < 12) { base = gates; ldc = 3072; col0 = pn * 256; act = 1; }
            else if (pn < 16) { base = apool; ldc = 1024; col0 = (pn - 12) * 256; act = 0; }
            else { base = uv; ldc = 2048; col0 = (pn - 16) * 256; act = 2; }
#pragma unroll
            for (int ai = 0; ai < 2; ++ai)
#pragma unroll
                for (int m = 0; m < 4; ++m) { bf16_t* rowp = base + (size_t)(row0 + ai * HALF + m * 16) * ldc + col0 + cl;
#pragma unroll
                    for (int bj = 0; bj < 2; ++bj) { f32x4 v0 = acc[ai][bj][m][0], v1 = acc[ai][bj][m][1];
                        if (act == 1) { v0 = sigm4(v0); v1 = sigm4(v1); }
                        else if (act == 2) { v0 = gelu4(v0); v1 = gelu4(v1); }
                        *(u32x4*)(rowp + bj * HALF) = pack8(v0, v1); } }
        } else {
            float* base = raw + (pn - 24) * 256 + cl;
#pragma unroll
            for (int ai = 0; ai < 2; ++ai)
#pragma unroll
                for (int m = 0; m < 4; ++m) { float* rowp = base + (size_t)(row0 + ai * HALF + m * 16) * 512;
#pragma unroll
                    for (int bj = 0; bj < 2; ++bj) { *(f32x4*)(rowp + bj * HALF) = acc[ai][bj][m][0]; *(f32x4*)(rowp + bj * HALF + 4) = acc[ai][bj][m][1]; } }
        }
    }
};
struct EpiQ {
    static constexpr bool PERM = true, AFTER_DRAIN = false;
    bf16_t* qp; const float* cosT; const float* sinT; int tok0;
    __device__ __forceinline__ void operator()(const f32x4 (&acc)[2][2][4][2], const Unit& u, int wr, int wc, int fr, int fq) const {
        const float SC = 0.10411754627697264f;
        const int row0 = u.pm * BM + wr * 64 + fr;
        if (u.pn < 4) {
#pragma unroll
            for (int ai = 0; ai < 2; ++ai)
#pragma unroll
                for (int m = 0; m < 4; ++m) { bf16_t* rowp = qp + (size_t)(row0 + ai * HALF + m * 16) * 1536 + wc * 32 + 8 * fq;
#pragma unroll
                    for (int bj = 0; bj < 2; ++bj) *(u32x4*)(rowp + (2 * u.pn + bj) * 192) = pack8(acc[ai][bj][m][0] * SC, acc[ai][bj][m][1] * SC); }
        } else {
            const int h = 4 * (u.pn - 4) + wc;
#pragma unroll
            for (int ai = 0; ai < 2; ++ai)
#pragma unroll
                for (int m = 0; m < 4; ++m) { const int row = row0 + ai * HALF + m * 16;
#pragma unroll
                    for (int n = 0; n < 2; ++n) { const int i0 = 8 * fq + 4 * n; const size_t tr = (size_t)(tok0 + row) * 32 + i0;
                        const f32x4 c0 = *(const f32x4*)(cosT + tr) * SC, s0 = *(const f32x4*)(sinT + tr) * SC, x1 = acc[ai][0][m][n], x2 = acc[ai][1][m][n];
                        const f32x4 o1 = x1 * c0 - x2 * s0, o2 = x2 * c0 + x1 * s0;
                        bf16_t* rowp = qp + (size_t)row * 1536 + h * 192 + 128 + i0;
                        u32x2 w1; w1.x = pk2(o1[0], o1[1]); w1.y = pk2(o1[2], o1[3]); u32x2 w2; w2.x = pk2(o2[0], o2[1]); w2.y = pk2(o2[2], o2[3]);
                        *(u32x2*)(rowp) = w1; *(u32x2*)(rowp + 32) = w2; }
                    asm volatile("" ::: "memory"); }
        }
    }
};
struct EpiBr {
    static constexpr bool PERM = true, AFTER_DRAIN = false;
    const bf16_t* gates; float* part; bf16_t* merged; int nM;
    __device__ __forceinline__ void operator()(const f32x4 (&acc)[2][2][4][2], const Unit& u, int wr, int wc, int fr, int fq) const {
        const int br = u.pn >> 2, pn = u.pn & 3, pm = u.pm - br * nM;
        const int row0 = pm * BM + wr * 64 + fr, cl = pn * 256 + wc * 32 + 8 * fq;
#pragma unroll
        for (int ai = 0; ai < 2; ++ai)
#pragma unroll
            for (int mp = 0; mp < 2; ++mp) {
                u32x4 gw[2][2]; f32x4 p0[2][2], p1[2][2];
#pragma unroll
                for (int mm = 0; mm < 2; ++mm) { const size_t row = (size_t)(row0 + ai * HALF + (2 * mp + mm) * 16);
#pragma unroll
                    for (int bj = 0; bj < 2; ++bj) { const int col = cl + bj * HALF; gw[mm][bj] = *(const u32x4*)(gates + row * 3072 + br * 1024 + col);
                        if (br != 0) { p0[mm][bj] = *(const f32x4*)(part + row * 1024 + col); p1[mm][bj] = *(const f32x4*)(part + row * 1024 + col + 4); } } }
                asm volatile("" ::: "memory"); __builtin_amdgcn_sched_barrier(0);
#pragma unroll
                for (int mm = 0; mm < 2; ++mm) { const int m = 2 * mp + mm; const size_t row = (size_t)(row0 + ai * HALF + m * 16);
#pragma unroll
                    for (int bj = 0; bj < 2; ++bj) { const int col = cl + bj * HALF; const u32x4 g = gw[mm][bj];
                        f32x4 v0 = acc[ai][bj][m][0] * (f32x4){bf_lo(g.x), bf_hi(g.x), bf_lo(g.y), bf_hi(g.y)};
                        f32x4 v1 = acc[ai][bj][m][1] * (f32x4){bf_lo(g.z), bf_hi(g.z), bf_lo(g.w), bf_hi(g.w)};
                        if (br != 0) { v0 += p0[mm][bj]; v1 += p1[mm][bj]; }
                        if (br != 2) { float* pp = part + row * 1024 + col; *(f32x4*)pp = v0; *(f32x4*)(pp + 4) = v1; }
                        else *(u32x4*)(merged + row * 1024 + col) = pack8(v0, v1); } }
            }
    }
};
struct EpiRes {
    static constexpr bool PERM = false, AFTER_DRAIN = false;
    const float* xin; float* xout; const float* gate; int tok0;
    __device__ __forceinline__ void operator()(const f32x4 (&acc)[2][2][4][2], const Unit& u, int wr, int wc, int fr, int fq) const {
        const float ALPHA = 1.4142135623730951f;
        const int grow0 = tok0 + u.pm * BM + wr * 64 + fr, col0 = u.pn * BM + wc * 32 + 4 * fq;
        const float* gp = gate + (size_t)((tok0 + u.pm * BM) >> 11) * 6144 + col0;
        f32x4 gv[2][2];
#pragma unroll
        for (int bj = 0; bj < 2; ++bj)
#pragma unroll
            for (int n = 0; n < 2; ++n) gv[bj][n] = *(const f32x4*)(gp + bj * HALF + n * 16);
#pragma unroll
        for (int ai = 0; ai < 2; ++ai)
#pragma unroll
            for (int m = 0; m < 4; ++m) { const size_t off = (size_t)(grow0 + ai * HALF + m * 16) * 1024 + col0;
#pragma unroll
                for (int bj = 0; bj < 2; ++bj)
#pragma unroll
                    for (int n = 0; n < 2; ++n) { const f32x4 xv = *(const f32x4*)(xin + off + bj * HALF + n * 16); *(f32x4*)(xout + off + bj * HALF + n * 16) = xv * ALPHA + gv[bj][n] * acc[ai][bj][m][n]; } }
    }
};
struct EpiUp {
    static constexpr bool PERM = true, AFTER_DRAIN = false;
    bf16_t* z; int ldc;
    __device__ __forceinline__ void operator()(const f32x4 (&acc)[2][2][4][2], const Unit& u, int wr, int wc, int fr, int fq) const {
        const int row0 = u.pm * BM + wr * 64 + fr, col0 = u.pn * BM + wc * 32 + 8 * fq;
#pragma unroll
        for (int ai = 0; ai < 2; ++ai)
#pragma unroll
            for (int m = 0; m < 4; ++m) { bf16_t* rowp = z + (size_t)(row0 + ai * HALF + m * 16) * ldc + col0;
#pragma unroll
                for (int bj = 0; bj < 2; ++bj) *(u32x4*)(rowp + bj * HALF) = pack8(acc[ai][bj][m][0], acc[ai][bj][m][1]); }
    }
};
__device__ __forceinline__ f32x4 dpp_ror(const f32x4 v, const int n) {
    f32x4 r;
#pragma unroll
    for (int j = 0; j < 4; ++j) { const float e = v[j]; const int x = __float_as_int(e); const int y = (n == 1) ? __builtin_amdgcn_update_dpp(0, x, 0x121, 0xF, 0xF, false) : __builtin_amdgcn_update_dpp(0, x, 0x122, 0xF, 0xF, false); r[j] = __int_as_float(y); }
    return r;
}
struct EpiUpConv {
    static constexpr bool PERM = true, AFTER_DRAIN = false;
    bf16_t* ff; float* zb; const float* cw; const float* cb;
    __device__ __forceinline__ void operator()(const f32x4 (&acc)[2][2][4][2], const Unit& u, int wr, int wc, int fr, int fq) const {
        const int cofs = 32 * wc + 8 * fq, colv0 = 128 * u.pn + cofs, zcol0 = 256 * u.pn + cofs;
        const bool f0 = (fr == 0), f01 = (fr < 2);
#pragma unroll
        for (int ai = 0; ai < 2; ++ai) {
            const int rowbase = u.pm * BM + ai * HALF + wr * 64, gi = rowbase >> 6;
#pragma unroll
            for (int n = 0; n < 2; ++n) {
                const float* pv = cw + colv0 + 4 * n; const float* pg = pv + 2816;
                const f32x4 wv0 = *(const f32x4*)pv, wv1 = *(const f32x4*)(pv + 5632), wv2 = *(const f32x4*)(pv + 2 * 5632), bv = *(const f32x4*)(cb + colv0 + 4 * n);
                const f32x4 wg0 = *(const f32x4*)pg, wg1 = *(const f32x4*)(pg + 5632), wg2 = *(const f32x4*)(pg + 2 * 5632), bg = *(const f32x4*)(cb + 2816 + colv0 + 4 * n);
                f32x4 p1v = {0.f, 0.f, 0.f, 0.f}, p2v = p1v, p1g = p1v, p2g = p1v;
#pragma unroll
                for (int m = 0; m < 4; ++m) { const f32x4 zv = acc[ai][0][m][n], zg = acc[ai][1][m][n];
                    const f32x4 t1v = dpp_ror(zv, 1), t2v = dpp_ror(zv, 2), t1g = dpp_ror(zg, 1), t2g = dpp_ror(zg, 2);
                    f32x4 vc = bv + wv2 * zv, gc = bg + wg2 * zg;
#pragma unroll
                    for (int j = 0; j < 4; ++j) { vc[j] += wv1[j] * (f0 ? p1v[j] : t1v[j]) + wv0[j] * (f01 ? p2v[j] : t2v[j]); gc[j] += wg1[j] * (f0 ? p1g[j] : t1g[j]) + wg0[j] * (f01 ? p2g[j] : t2g[j]); }
                    const f32x4 o = gc * sigm4(gc) * vc;
                    if (m > 0 || !f01) { u32x2 w; w.x = pk2(o[0], o[1]); w.y = pk2(o[2], o[3]); *(u32x2*)(ff + (size_t)(rowbase + 16 * m + fr) * 2816 + colv0 + 4 * n) = w; }
                    p1v = t1v; p2v = t2v; p1g = t1g; p2g = t2g; }
                asm volatile("" ::: "memory");
            }
            if (f01) { float* zp = zb + ((size_t)gi * 4 + fr) * 5632 + zcol0;
#pragma unroll
                for (int bj = 0; bj < 2; ++bj) { *(f32x4*)(zp + bj * HALF) = acc[ai][bj][0][0]; *(f32x4*)(zp + bj * HALF + 4) = acc[ai][bj][0][1]; } }
            if (fr >= 14) { float* zp = zb + ((size_t)gi * 4 + (fr - 12)) * 5632 + zcol0;
#pragma unroll
                for (int bj = 0; bj < 2; ++bj) { *(f32x4*)(zp + bj * HALF) = acc[ai][bj][3][0]; *(f32x4*)(zp + bj * HALF + 4) = acc[ai][bj][3][1]; } }
        }
    }
};
struct BrOrder {
    StaticOrder base; int nM;
    __device__ void init(int M, int G_, int c_) { base.init(M, 1024, G_, c_); nM = M / BM; }
    __device__ bool next(int i, Unit& u) const { const int ti = i / 3, br = i - 3 * ti; Unit t; if (!base.next(ti, t)) return false; u.pm = br * nM + t.pm; u.pn = br * 4 + t.pn; return true; }
    __device__ __forceinline__ void a_ready(const Unit&) const {}
    __device__ __forceinline__ void done(const Unit&) const {}
};

template <class Epi, class Sched, bool ALIGN_EPI = false, bool SP2 = false>
__device__ __forceinline__ void gemm_phase(PG8_LAS unsigned char* lds, const Gemm g, const Sched& S, const Epi& E) {
    int tid_ = threadIdx.x; asm volatile("" : "+v"(tid_));
    const int tid = tid_, wid = __builtin_amdgcn_readfirstlane(tid >> 6), lane = tid & 63, wr = wid >> 2, wc = wid & 3, fr = lane & 15, fq = lane >> 4;
    const int K = g.K, nt = K / BK;
    unsigned voffA[2], voffB[2];
#pragma unroll
    for (int i = 0; i < 2; ++i) { int R, C; stage_rc(tid * 16 + i * 8192, R, C); const int Rb = Epi::PERM ? ((R & ~31) + perm32(R & 31)) : R;
        voffA[i] = (unsigned)(R * K + C) * 2u; voffB[i] = (unsigned)(Rb * K + C) * 2u; }
    const size_t kstep = (size_t)(BK * 2);
    const size_t hstep = (size_t)HALF * K * 2;
    const size_t tstep = 2 * hstep;
    const unsigned ldsw = (unsigned)wid * 1024u;
    const int aoff = lds_byte(wr * 64 + fr, fq * 8), boff = lds_byte(wc * 32 + fr, fq * 8);
#define PG8_SA(b, h) (((b) * 2 + (h)) * HTB)
#define PG8_SB(b, h) ((4 + (b) * 2 + (h)) * HTB)
#define PG8_STAGE(bufoff, gbase, voff) do { _Pragma("unroll") for (int _i = 0; _i < 2; ++_i) \
        __builtin_amdgcn_global_load_lds((const unsigned*)((const char*)(gbase) + (voff)[_i]), (PG8_LAS unsigned*)(lds + (bufoff) + ldsw + _i * 8192), 16, 0, 0); } while (0)
#define PG8_LDA(dst, b, h) do { _Pragma("unroll") for (int m = 0; m < 4; ++m) _Pragma("unroll") for (int k = 0; k < 2; ++k) dst[m][k] = *(const PG8_LAS bf16x8*)(lds + PG8_SA(b, h) + aoff + m * 2048 + k * 1024); } while (0)
#define PG8_LDB(dst, b, h) do { _Pragma("unroll") for (int n = 0; n < 2; ++n) _Pragma("unroll") for (int k = 0; k < 2; ++k) dst[n][k] = *(const PG8_LAS bf16x8*)(lds + PG8_SB(b, h) + boff + n * 2048 + k * 1024); } while (0)
#define PG8_MMA(ai, bj, At, Bt) do { __builtin_amdgcn_s_setprio(1); _Pragma("unroll") for (int m = 0; m < 4; ++m) _Pragma("unroll") for (int n = 0; n < 2; ++n) _Pragma("unroll") for (int k = 0; k < 2; ++k) \
        acc[ai][bj][m][n] = __builtin_amdgcn_mfma_f32_16x16x32_bf16(Bt[n][k], At[m][k], acc[ai][bj][m][n], 0, 0, 0); __builtin_amdgcn_s_setprio(0); } while (0)
#define PG8_WAIT_V(n) asm volatile("s_waitcnt vmcnt(" #n ")" ::: "memory")
#define PG8_WAIT_L(n) asm volatile("s_waitcnt lgkmcnt(" #n ")" ::: "memory")
#define PG8_BAR __builtin_amdgcn_s_barrier()
#define PG8_SCHED __builtin_amdgcn_sched_barrier(0)
    Unit cur, nxt; int ui = 0;
    if (!S.next(0, cur)) return;
    f32x4 acc[2][2][4][2];
#pragma unroll
    for (int a = 0; a < 2; ++a)
#pragma unroll
        for (int b = 0; b < 2; ++b)
#pragma unroll
            for (int m = 0; m < 4; ++m)
#pragma unroll
                for (int n = 0; n < 2; ++n) acc[a][b][m][n] = (f32x4){0.f, 0.f, 0.f, 0.f};
    bf16x8 At[4][2], B0[2][2], B1[2][2];
    const char* cA = (const char*)g.A + (size_t)cur.pm * tstep; const char* cB = (const char*)g.Bt + (size_t)cur.pn * tstep;
    S.a_ready(cur);
    if constexpr (SP2) {
        PG8_STAGE(PG8_SB(0, 0), cB, voffB); PG8_STAGE(PG8_SB(0, 1), cB + hstep, voffB); PG8_STAGE(PG8_SA(0, 0), cA, voffA); PG8_STAGE(PG8_SA(0, 1), cA + hstep, voffA);
        if (wr == 1) PG8_BAR;
        PG8_WAIT_V(2); PG8_BAR;
        PG8_STAGE(PG8_SB(1, 0), cB + kstep, voffB); PG8_STAGE(PG8_SA(1, 0), cA + kstep, voffA); PG8_STAGE(PG8_SB(1, 1), cB + hstep + kstep, voffB);
        PG8_WAIT_V(6); PG8_BAR;
    } else {
        PG8_STAGE(PG8_SB(0, 0), cB, voffB); PG8_STAGE(PG8_SA(0, 0), cA, voffA); PG8_STAGE(PG8_SB(0, 1), cB + hstep, voffB); PG8_STAGE(PG8_SA(0, 1), cA + hstep, voffA);
        if (wr == 1) PG8_BAR;
        PG8_WAIT_V(4); PG8_BAR;
        PG8_STAGE(PG8_SB(1, 0), cB + kstep, voffB); PG8_STAGE(PG8_SA(1, 0), cA + kstep, voffA); PG8_STAGE(PG8_SB(1, 1), cB + hstep + kstep, voffB);
        PG8_WAIT_V(6); PG8_BAR;
    }
    for (;;) {
        const bool has_next = S.next(ui + 1, nxt);
        const char* nA = has_next ? (const char*)g.A + (size_t)nxt.pm * tstep : cA; const char* nB = has_next ? (const char*)g.Bt + (size_t)nxt.pn * tstep : cB;
        for (int t = 0; t < nt; t += 2) {
            const bool last = (t == nt - 2);
            const char* a1 = cA + (size_t)(t + 1) * kstep;
            const char* a2 = last ? nA : cA + (size_t)(t + 2) * kstep; const char* b2 = last ? nB : cB + (size_t)(t + 2) * kstep;
            const char* a3 = a2 + kstep; const char* b3 = b2 + kstep;
            if (last && has_next) S.a_ready(nxt);
            if constexpr (SP2) {
            PG8_LDB(B0, 0, 0); PG8_LDB(B1, 0, 1); PG8_SCHED; PG8_LDA(At, 0, 0); PG8_STAGE(PG8_SA(1, 1), a1 + hstep, voffA);
            PG8_WAIT_V(8); PG8_WAIT_L(0); PG8_BAR; PG8_MMA(0, 0, At, B0); PG8_MMA(0, 1, At, B1); PG8_BAR; PG8_SCHED;
            PG8_LDA(At, 0, 1); PG8_STAGE(PG8_SB(0, 0), b2, voffB); PG8_STAGE(PG8_SB(0, 1), b2 + hstep, voffB); PG8_STAGE(PG8_SA(0, 0), a2, voffA);
            PG8_WAIT_V(8); PG8_WAIT_L(0); PG8_BAR; PG8_MMA(1, 0, At, B0); PG8_MMA(1, 1, At, B1); PG8_BAR; PG8_SCHED;
            PG8_LDB(B0, 1, 0); PG8_LDB(B1, 1, 1); PG8_SCHED; PG8_LDA(At, 1, 0); PG8_STAGE(PG8_SA(0, 1), a2 + hstep, voffA);
            PG8_WAIT_V(8); PG8_WAIT_L(0); PG8_BAR; PG8_MMA(0, 0, At, B0); PG8_MMA(0, 1, At, B1); PG8_BAR; PG8_SCHED;
            PG8_LDA(At, 1, 1); PG8_STAGE(PG8_SB(1, 0), b3, voffB); PG8_STAGE(PG8_SB(1, 1), b3 + hstep, voffB); PG8_STAGE(PG8_SA(1, 0), a3, voffA);
            PG8_WAIT_V(8); PG8_WAIT_L(0); PG8_BAR; PG8_MMA(1, 0, At, B0); PG8_MMA(1, 1, At, B1); PG8_BAR; PG8_SCHED;
            } else {
            PG8_LDB(B0, 0, 0); PG8_SCHED; PG8_LDA(At, 0, 0); PG8_STAGE(PG8_SA(1, 1), a1 + hstep, voffA);
            PG8_WAIT_L(8); PG8_BAR; PG8_WAIT_L(0); PG8_MMA(0, 0, At, B0); PG8_BAR; PG8_SCHED;
            PG8_LDB(B1, 0, 1); PG8_STAGE(PG8_SB(0, 0), b2, voffB);
            PG8_BAR; PG8_WAIT_L(0); PG8_MMA(0, 1, At, B1); PG8_BAR;
            PG8_LDA(At, 0, 1); PG8_STAGE(PG8_SA(0, 0), a2, voffA);
            PG8_BAR; PG8_WAIT_L(0); PG8_MMA(1, 0, At, B0); PG8_BAR; PG8_SCHED;
            PG8_STAGE(PG8_SB(0, 1), b2 + hstep, voffB);
            PG8_WAIT_V(6); PG8_BAR; PG8_MMA(1, 1, At, B1); PG8_BAR;
            PG8_LDB(B0, 1, 0); PG8_SCHED; PG8_LDA(At, 1, 0); PG8_STAGE(PG8_SA(0, 1), a2 + hstep, voffA);
            PG8_WAIT_L(8); PG8_BAR; PG8_WAIT_L(0); PG8_MMA(0, 0, At, B0); PG8_BAR; PG8_SCHED;
            PG8_LDB(B1, 1, 1); PG8_STAGE(PG8_SB(1, 0), b3, voffB);
            PG8_BAR; PG8_WAIT_L(0); PG8_MMA(0, 1, At, B1); PG8_BAR;
            PG8_LDA(At, 1, 1); PG8_STAGE(PG8_SA(1, 0), a3, voffA);
            PG8_BAR; PG8_WAIT_L(0); PG8_MMA(1, 0, At, B0); PG8_BAR; PG8_SCHED;
            PG8_STAGE(PG8_SB(1, 1), b3 + hstep, voffB);
            PG8_WAIT_V(6); PG8_BAR; PG8_MMA(1, 1, At, B1); PG8_BAR;
            }
        }
        if constexpr (ALIGN_EPI) { if (wr == 0) PG8_BAR; }
        if constexpr (!Epi::AFTER_DRAIN) { E(acc, cur, wr, wc, fr, fq); S.done(cur); }
        if (!has_next) break;
#pragma unroll
        for (int a = 0; a < 2; ++a)
#pragma unroll
            for (int b = 0; b < 2; ++b)
#pragma unroll
                for (int m = 0; m < 4; ++m)
#pragma unroll
                    for (int n = 0; n < 2; ++n) acc[a][b][m][n] = (f32x4){0.f, 0.f, 0.f, 0.f};
        cur = nxt; cA = nA; cB = nB; ++ui;
        if constexpr (ALIGN_EPI) { if (wr == 1) PG8_BAR; }
    }
    PG8_WAIT_V(0);
    if constexpr (!ALIGN_EPI) { if (wr == 0) PG8_BAR; }
    PG8_BAR;
    if constexpr (Epi::AFTER_DRAIN) { E.fused(acc, cur, wr, wc, fr, fq, lds, wid, lane); S.done(cur); }
#undef PG8_SA
#undef PG8_SB
#undef PG8_STAGE
#undef PG8_LDA
#undef PG8_LDB
#undef PG8_MMA
#undef PG8_WAIT_V
#undef PG8_WAIT_L
#undef PG8_BAR
#undef PG8_SCHED
}
}


#define LAS __attribute__((address_space(3)))
typedef unsigned short bf16_t;
typedef float f32x4 __attribute__((ext_vector_type(4)));
typedef float f32x16 __attribute__((ext_vector_type(16)));
typedef unsigned u32x4 __attribute__((ext_vector_type(4)));
typedef unsigned u32x2 __attribute__((ext_vector_type(2)));
typedef short bf16x8 __attribute__((ext_vector_type(8)));
typedef short s16x4 __attribute__((ext_vector_type(4)));
using pg8::pk2; using pg8::bf_lo; using pg8::bf_hi; using pg8::pack8;

constexpr int T_ALL = 65536, SEQ = 2048, NBATCH = 32, DM = 1024, NS = 2, TS = T_ALL / NS, BPS = NBATCH / NS;
constexpr int IN_W = 6592, N1 = 6656, NQ = 1536, DFF = 2816, NUP = 5632;
constexpr size_t MiB = 1u << 20;
constexpr size_t OFF_MOD = 0, OFF_COS = 2 * MiB, OFF_SIN = 10 * MiB, OFF_WSB = 18 * MiB, OFF_WL = 20 * MiB, WL_STRIDE = 40 * MiB;
constexpr size_t WO_W1 = 0, WO_WQ = 13 * MiB, WO_WBR = 14 * MiB, WO_WO = 20 * MiB, WO_WUP = 22 * MiB, WO_WDN = 33 * MiB;
constexpr size_t OFF_H = 128 * MiB, OFF_GATES = 192 * MiB, OFF_APOOL = 384 * MiB, OFF_RAW = 448 * MiB, OFF_PART = 384 * MiB, OFF_UV = 512 * MiB, OFF_QP = 512 * MiB,
                 OFF_BR = 640 * MiB, OFF_CQN = 832 * MiB, OFF_K192 = 848 * MiB, OFF_VT = 860 * MiB, OFF_Z = 192 * MiB, OFF_FF = 544 * MiB, OFF_Y = 720 * MiB, WS_NEED = 868 * MiB;
constexpr int LDS_BYTES = 147456, LDS_BARST = 131072 + 256;
constexpr size_t OFF_BAR = 1835008, BAR_BYTES = 16384;
constexpr float LN_EPS = 1e-5f, RMS_EPS = 1e-6f;

struct Params {
    const float* x; const float* c; const int* pos; const float* w_ada; const float* b_ada; const float* w_in; const float* w_pool; const float* s_pool; const float* g_q; const float* w_uq;
    const float* g_kv; const float* w_ukv; const float* g_sg; const float* b_sg; const float* w_s; const float* b_s; const float* w_branch; const float* w_o; const float* ln_t_g; const float* ln_t_b;
    const float* w_up; const float* conv_w; const float* conv_b; const float* w_down; const float* ln_f_g; const float* ln_f_b;
    float* out; unsigned char* ws;
};

#define LOADS_DONE() do { asm volatile("" ::: "memory"); __builtin_amdgcn_sched_barrier(0); } while (0)
__device__ __forceinline__ int tid_opaque() { int t = threadIdx.x; asm volatile("" : "+v"(t)); return t; }
__device__ __forceinline__ float dpp_f(float v, const int ctrl_sel) {
    const int x = __builtin_bit_cast(int, v); int r;
    if (ctrl_sel == 0) r = __builtin_amdgcn_update_dpp(0, x, 0xB1, 0xF, 0xF, true);
    else if (ctrl_sel == 1) r = __builtin_amdgcn_update_dpp(0, x, 0x4E, 0xF, 0xF, true);
    else if (ctrl_sel == 2) r = __builtin_amdgcn_update_dpp(0, x, 0x141, 0xF, 0xF, true);
    else r = __builtin_amdgcn_update_dpp(0, x, 0x140, 0xF, 0xF, true);
    return __builtin_bit_cast(float, r);
}
__device__ __forceinline__ float wave_sum(float v) {
    v += dpp_f(v, 0); v += dpp_f(v, 1); v += dpp_f(v, 2); v += dpp_f(v, 3);
    const int x = __builtin_bit_cast(int, v);
    const float r0 = __builtin_bit_cast(float, __builtin_amdgcn_readlane(x, 0)), r1 = __builtin_bit_cast(float, __builtin_amdgcn_readlane(x, 16)),
                r2 = __builtin_bit_cast(float, __builtin_amdgcn_readlane(x, 32)), r3 = __builtin_bit_cast(float, __builtin_amdgcn_readlane(x, 48));
    return (r0 + r1) + (r2 + r3);
}

#define XB_TMO      128
#define XB_XCNT(j)  (256  + 64 * (j))
#define XB_XSUB(j)  (1280 + 64 * (j))
#define XB_XGEN(j)  (2304 + 64 * (j))
#define XB_TOP      3328
#define XB_TOPGEN   3392
#define XCD_BAR_WORDS 3456
#define XB_SPIN_CAP (1u << 18)

__device__ __forceinline__ unsigned xb_ld(unsigned* p)              { return __hip_atomic_load(p, __ATOMIC_RELAXED, __HIP_MEMORY_SCOPE_AGENT); }
__device__ __forceinline__ unsigned xb_add(unsigned* p, unsigned v) { return __hip_atomic_fetch_add(p, v, __ATOMIC_RELAXED, __HIP_MEMORY_SCOPE_AGENT); }
__device__ __forceinline__ unsigned xb_xcc_id() { return (unsigned)__builtin_amdgcn_s_getreg((3 << 11) | 20) & 0xFu; }
#define XB_SPIN(cond, bar) do { unsigned _sp = 0; while (cond) { __builtin_amdgcn_s_sleep(1); \
    if ((++_sp & 255u) == 0u) { if (xb_ld(&(bar)[XB_TMO])) break; if (_sp > XB_SPIN_CAP) { atomicAdd(&(bar)[XB_TMO], 1u); break; } } } } while (0)

struct XcdBarrier {
    unsigned* bar; unsigned x;
    volatile LAS unsigned* st;
};

__device__ __forceinline__ XcdBarrier xcd_barrier_post(unsigned* bar, volatile LAS unsigned* st) {
    XcdBarrier b; b.bar = bar; b.x = xb_xcc_id(); b.st = st;
    if (threadIdx.x == 0) (void)xb_add(&bar[XB_XCNT(b.x)], 1u);
    return b;
}
__device__ __forceinline__ void xcd_barrier_complete(unsigned* bar, unsigned x, unsigned& nloc, unsigned& nx) {
    const unsigned G = gridDim.x * gridDim.y * gridDim.z;
    unsigned sum, cnt, mine, sp = 0u;
    for (;;) {
        sum = 0u; cnt = 0u; mine = 0u;
#pragma unroll
        for (unsigned j = 0; j < 16; ++j) { const unsigned c = xb_ld(&bar[XB_XCNT(j)]); sum += c; cnt += (c > 0u) ? 1u : 0u; mine = (j == x) ? c : mine; }
        if (sum == G) break;
        __builtin_amdgcn_s_sleep(1);
        if ((++sp & 255u) == 0u) { if (xb_ld(&bar[XB_TMO])) break; if (sp > XB_SPIN_CAP) { atomicAdd(&bar[XB_TMO], 1u); break; } }
    }
    nloc = mine > 0u ? mine : 1u; nx = cnt > 0u ? cnt : 1u;
}

__device__ __forceinline__ void xcd_barrier(const XcdBarrier& b) {
    asm volatile("s_waitcnt vmcnt(0)" ::: "memory");
    __syncthreads();
    if (threadIdx.x == 0) {
        unsigned* bar = b.bar;
        __builtin_amdgcn_s_waitcnt(0);
        unsigned nloc = b.st[0], nx = b.st[1];
        if (nloc == 0u) { xcd_barrier_complete(bar, b.x, nloc, nx); b.st[0] = nloc; b.st[1] = nx; }
        const unsigned old = xb_add(&bar[XB_XSUB(b.x)], 1u);
        const unsigned gen = old / nloc;
        if (old + 1u == (gen + 1u) * nloc) {
            __builtin_amdgcn_fence(__ATOMIC_RELEASE, "agent");
            asm volatile("s_waitcnt vmcnt(0)" ::: "memory");
            const unsigned og = xb_add(&bar[XB_TOP], 1u);
            const unsigned tg = og / nx;
            if (og + 1u == (tg + 1u) * nx) xb_add(&bar[XB_TOPGEN], 1u);
            else XB_SPIN(xb_ld(&bar[XB_TOPGEN]) == tg, bar);
            __builtin_amdgcn_fence(__ATOMIC_ACQUIRE, "agent");
            xb_add(&bar[XB_XGEN(b.x)], 1u);
            asm volatile("s_waitcnt vmcnt(0)" ::: "memory");
        } else {
            XB_SPIN(xb_ld(&bar[XB_XGEN(b.x)]) == gen, bar);
            __builtin_amdgcn_fence(__ATOMIC_ACQUIRE, "agent");
            asm volatile("s_waitcnt vmcnt(0)" ::: "memory");
        }
    }
    __syncthreads();
}


__device__ __forceinline__ void xpose_tile(const float* src, int ld, int k0, int c0, bf16_t* dst, int ldd, int n0, LAS float* tile) {
    const int tid = tid_opaque(), r = tid >> 3, cc = (tid & 7) * 8;
    f32x4 a = {0.f, 0.f, 0.f, 0.f}, b = {0.f, 0.f, 0.f, 0.f};
    if (c0 >= 0) { const float* s = src + (size_t)(k0 + r) * ld + c0 + cc; a = *(const f32x4*)s; b = *(const f32x4*)(s + 4); }
#pragma unroll
    for (int e = 0; e < 4; ++e) { tile[r * 65 + cc + e] = a[e]; tile[r * 65 + cc + 4 + e] = b[e]; }
    __syncthreads();
    float v[8];
#pragma unroll
    for (int e = 0; e < 8; ++e) v[e] = tile[(cc + e) * 65 + r];
    u32x4 w; w.x = pk2(v[0], v[1]); w.y = pk2(v[2], v[3]); w.z = pk2(v[4], v[5]); w.w = pk2(v[6], v[7]);
    *(u32x4*)(dst + (size_t)(n0 + r) * ldd + k0 + cc) = w;
    __syncthreads();
}

typedef const Params __attribute__((address_space(4)))* KPtr;
__device__ __forceinline__ KPtr kparams() { KPtr k = (KPtr)__builtin_amdgcn_kernarg_segment_ptr(); asm volatile("" : "+s"(k)); return k; }
__device__ __forceinline__ void prep_phase(KPtr pp, LAS unsigned char* lds, int G, int bid) {
    const int tid = tid_opaque(), lane = tid & 63, wid = tid >> 6;
    const int gtid = bid * 512 + tid, gsz = G * 512;
    unsigned char* ws = pp->ws;
    { float* COS = (float*)(ws + OFF_COS); float* SIN = (float*)(ws + OFF_SIN);
      for (int i = gtid; i < T_ALL * 32; i += gsz) {
          const int t = i >> 5, f = i & 31;
          double fr = 1.0; for (int k = 0; k < f; ++k) fr *= 0.7498942093324559;
          const double ang = (double)pp->pos[t] * fr;
          const double kq = __builtin_rint(ang * 0.15915494309189535);
          double r = __builtin_fma(-kq, 6.283185307179586, ang); r = __builtin_fma(-kq, 2.4492935982947064e-16, r);
          const double r2 = r * r; double sn = 1.0, cs = 1.0;
          _Pragma("unroll") for (int k = 15; k >= 1; --k) { sn = 1.0 - sn * r2 * (1.0 / (double)((2 * k) * (2 * k + 1))); cs = 1.0 - cs * r2 * (1.0 / (double)((2 * k - 1) * (2 * k))); }
          COS[i] = (float)cs; SIN[i] = (float)(sn * r);
      } }
    { bf16_t* WSB = (bf16_t*)(ws + OFF_WSB);
      for (int i = gtid; i < 2 * 8 * 128 * 128 / 2; i += gsz) { const int e = i * 2, tt = (e >> 7) & 127, ss = e & 127;
          const float a = ss <= tt ? pp->w_s[e] : 0.f, b = (ss + 1) <= tt ? pp->w_s[e + 1] : 0.f; ((unsigned*)WSB)[i] = pk2(a, b); } }
    { LAS float* tile = (LAS float*)lds;
      const int r = tid >> 3, cc = (tid & 7) * 8;
      for (int tb4 = bid * 4; tb4 < 2 * 4288; tb4 += G * 4) {
          f32x4 va[4], vb[4]; bf16_t* dptr[4];
#pragma unroll
          for (int q = 0; q < 4; ++q) {
              const int ti = tb4 + q; const int l = ti / 4288; int rr = ti - l * 4288; unsigned char* wl = ws + OFF_WL + (size_t)l * WL_STRIDE;
              const float* src; int ld, k0, c0, ldd, n0; bf16_t* dst;
              if (rr < 1664) { const int nb = rr >> 4, kb = rr & 15; n0 = nb * 64; k0 = kb * 64;
                  if (n0 < 4096) c0 = n0; else if (n0 < 6144) c0 = 4544 + (n0 - 4096); else if (n0 < 6400) c0 = 4096 + (n0 - 6144); else if (n0 < 6528) c0 = 4352 + (n0 - 6400); else if (n0 < 6592) c0 = 4480 + (n0 - 6528); else c0 = -1;
                  src = pp->w_in + (size_t)l * 1024 * IN_W; ld = IN_W; dst = (bf16_t*)(wl + WO_W1); ldd = 1024; }
              else if (rr < 1920) { rr -= 1664; const int nb = rr >> 4, kb = rr & 15; n0 = nb * 64; k0 = kb * 64; c0 = n0; src = pp->w_branch + ((size_t)l * 3 + 2) * 1048576; ld = 1024; dst = (bf16_t*)(wl + WO_WBR) + 2 * 1048576; ldd = 1024; }
              else if (rr < 2176) { rr -= 1920; const int nb = rr >> 4, kb = rr & 15; n0 = nb * 64; k0 = kb * 64; c0 = n0; src = pp->w_o + (size_t)l * 1048576; ld = 1024; dst = (bf16_t*)(wl + WO_WO); ldd = 1024; }
              else if (rr < 3584) { rr -= 2176; const int nb = rr >> 4, kb = rr & 15; n0 = nb * 64; k0 = kb * 64; const int uu = n0 >> 8, cc0 = n0 & 255; c0 = (cc0 >> 7) * DFF + 128 * uu + (cc0 & 127);
                  src = pp->w_up + (size_t)l * 1024 * NUP; ld = NUP; dst = (bf16_t*)(wl + WO_WUP); ldd = 1024; }
              else { rr -= 3584; const int nb = rr / 44, kb = rr - nb * 44; n0 = nb * 64; k0 = kb * 64; c0 = n0; src = pp->w_down + (size_t)l * DFF * 1024; ld = 1024; dst = (bf16_t*)(wl + WO_WDN); ldd = DFF; }
              if (c0 >= 0) { const float* s = src + (size_t)(k0 + r) * ld + c0 + cc; va[q] = *(const f32x4*)s; vb[q] = *(const f32x4*)(s + 4); }
              else { va[q] = (f32x4){0.f, 0.f, 0.f, 0.f}; vb[q] = (f32x4){0.f, 0.f, 0.f, 0.f}; }
              dptr[q] = dst + (size_t)(n0 + r) * ldd + k0 + cc;
          }
#pragma unroll
          for (int q = 0; q < 4; ++q)
#pragma unroll
              for (int e = 0; e < 4; ++e) { tile[q * 4160 + r * 65 + cc + e] = va[q][e]; tile[q * 4160 + r * 65 + cc + 4 + e] = vb[q][e]; }
          __syncthreads();
#pragma unroll
          for (int q = 0; q < 4; ++q) { float v[8];
#pragma unroll
              for (int e = 0; e < 8; ++e) v[e] = tile[q * 4160 + (cc + e) * 65 + r];
              u32x4 w; w.x = pk2(v[0], v[1]); w.y = pk2(v[2], v[3]); w.z = pk2(v[4], v[5]); w.w = pk2(v[6], v[7]);
              *(u32x4*)dptr[q] = w; }
          __syncthreads();
      } }
    for (int item = bid * 8 + wid; item < 1024; item += G * 8) { const int l = item >> 9, h = (item >> 6) & 7, jb = (item >> 2) & 15, r = (item & 3) * 64 + lane;
        const float* a = pp->w_uq + ((size_t)(l * 256 + r) * 8 + h) * 192; const float* b = pp->w_ukv + ((size_t)(l * 128 + jb * 8) * 8 + h) * 256; float acc[8];
#pragma unroll
        for (int i = 0; i < 8; ++i) acc[i] = 0.f;
#pragma unroll 4
        for (int d = 0; d < 128; d += 4) { const f32x4 av = *(const f32x4*)(a + d);
#pragma unroll
            for (int i = 0; i < 8; ++i) { const f32x4 bv = *(const f32x4*)(b + (size_t)i * 2048 + d); acc[i] += (av[0] * bv[0] + av[1] * bv[1]) + (av[2] * bv[2] + av[3] * bv[3]); } }
        bf16_t* dq = (bf16_t*)(ws + OFF_WL + (size_t)l * WL_STRIDE + WO_WQ) + (size_t)(h * 128 + jb * 8) * 256 + r;
#pragma unroll
        for (int i = 0; i < 8; ++i) dq[(size_t)i * 256] = (bf16_t)(pk2(acc[i], 0.f) & 0xffffu); }
    for (int i = gtid; i < 2 * 512 * 256; i += gsz) { const int l = i >> 17, n = (i >> 8) & 511, r = i & 255, u2 = n >> 8, cc = n & 255, bj = cc >> 7, h = 4 * u2 + ((cc >> 5) & 3), dd = 128 + (cc & 31) + 32 * bj;
        const float v = pp->w_uq[((size_t)(l * 256 + r) * 8 + h) * 192 + dd];
        ((bf16_t*)(ws + OFF_WL + (size_t)l * WL_STRIDE + WO_WQ))[(size_t)(1024 + n) * 256 + r] = (bf16_t)(pk2(v, 0.f) & 0xffffu); }
    for (int item = bid * 8 + wid; item < 8192; item += G * 8) { const int l = item >> 12, which = (item >> 11) & 1, kk = ((item >> 7) & 15) * 64 + lane, n0 = (item & 127) * 8;
        const float* a; const float* b; const float* sp = nullptr; int K;
        if (which == 1) { const int h = kk >> 7, j = kk & 127; a = pp->w_ukv + ((size_t)(l * 128 + j) * 8 + h) * 256 + 128; b = pp->w_branch + ((size_t)(l * 3 + 1) * 1024 + (size_t)__builtin_amdgcn_readfirstlane(h) * 128) * 1024 + n0; K = 128; }
        else { const int g = __builtin_amdgcn_readfirstlane(kk >> 8), c = kk & 255; a = pp->w_pool + ((size_t)(l * 4 + g) * 256 + c) * 256; sp = pp->s_pool + l * 1024 + g * 256; b = pp->w_branch + ((size_t)(l * 3 + 0) * 1024 + g * 256) * 1024 + n0; K = 256; }
        float acc[8];
#pragma unroll
        for (int i = 0; i < 8; ++i) acc[i] = 0.f;
#pragma unroll 2
        for (int d = 0; d < K; d += 4) { f32x4 av = *(const f32x4*)(a + d); if (sp) av *= *(const f32x4*)(sp + d);
#pragma unroll
            for (int dd = 0; dd < 4; ++dd) { const f32x4 b0 = *(const f32x4*)(b + (size_t)(d + dd) * 1024), b1 = *(const f32x4*)(b + (size_t)(d + dd) * 1024 + 4);
                acc[0] += av[dd] * b0[0]; acc[1] += av[dd] * b0[1]; acc[2] += av[dd] * b0[2]; acc[3] += av[dd] * b0[3]; acc[4] += av[dd] * b1[0]; acc[5] += av[dd] * b1[1]; acc[6] += av[dd] * b1[2]; acc[7] += av[dd] * b1[3]; } }
        bf16_t* dw = (bf16_t*)(ws + OFF_WL + (size_t)l * WL_STRIDE + WO_WBR) + ((size_t)which * 1024 + n0) * 1024 + kk;
#pragma unroll
        for (int i = 0; i < 8; ++i) dw[(size_t)i * 1024] = (bf16_t)(pk2(acc[i], 0.f) & 0xffffu); }
    { LAS float* tab = (LAS float*)lds; LAS float* part = tab + 16384; float* MOD = (float*)(ws + OFF_MOD);
      __syncthreads();
      for (int it = bid; it < 384; it += G) { const int l = it / 192, rem = it - l * 192, nc = rem >> 1, bh = rem & 1;
          for (int i = tid; i < 16384; i += 512) { const int k = i >> 4, bb = i & 15; const float cv = pp->c[(bh * 16 + bb) * 1024 + k]; tab[i] = cv / (1.0f + __expf(-cv)); }
          __syncthreads();
          float acc[16];
#pragma unroll
          for (int b = 0; b < 16; ++b) acc[b] = 0.f;
          const float* wp = pp->w_ada + ((size_t)l * 1024 + wid * 128) * 6144 + nc * 64 + lane;
          _Pragma("unroll 8") for (int k = 0; k < 128; ++k) { const float wv = wp[(size_t)k * 6144]; const LAS f32x4* tp = (const LAS f32x4*)(tab + (wid * 128 + k) * 16);
#pragma unroll
              for (int q = 0; q < 4; ++q) { const f32x4 tv = tp[q]; acc[4 * q] += tv[0] * wv; acc[4 * q + 1] += tv[1] * wv; acc[4 * q + 2] += tv[2] * wv; acc[4 * q + 3] += tv[3] * wv; } }
#pragma unroll
          for (int b = 0; b < 16; ++b) part[(wid * 16 + b) * 64 + lane] = acc[b];
          __syncthreads();
          for (int o = tid; o < 1024; o += 512) { const int bb = o >> 6, nn = o & 63; float s = pp->b_ada[l * 6144 + nc * 64 + nn];
#pragma unroll
              for (int w = 0; w < 8; ++w) s += part[(w * 16 + bb) * 64 + nn];
              MOD[(size_t)(l * 32 + bh * 16 + bb) * 6144 + nc * 64 + nn] = s; }
          __syncthreads();
      } }
}

__device__ __forceinline__ void row_stats(const f32x4 (&v)[4], float& mean, float& rstd) {
    float s = 0.f;
#pragma unroll
    for (int q = 0; q < 4; ++q) s += (v[q][0] + v[q][1]) + (v[q][2] + v[q][3]);
    mean = wave_sum(s) * (1.0f / 1024.0f); float qq = 0.f;
#pragma unroll
    for (int q = 0; q < 4; ++q) { const f32x4 d = v[q] - mean; qq += (d[0] * d[0] + d[1] * d[1]) + (d[2] * d[2] + d[3] * d[3]); }
    rstd = 1.0f / sqrtf(wave_sum(qq) * (1.0f / 1024.0f) + LN_EPS);
}
template <int MODE, bool HOUT>
__device__ __forceinline__ void ln_pass(const float* xin, const bf16_t* yin, const float* gate, float* xout, bf16_t* hout, int tok0, const float* lng, const float* lnb, const float* modsh, const float* modsc, int G, int bid) {
    const int tid = tid_opaque(), lane = tid & 63, wid = tid >> 6;
    const float ALPHA = 1.4142135623730951f;
    constexpr int NR = 4, RPB = SEQ;
    const int nwaves = G * 8, wpb = nwaves / BPS;
    const int gw = bid * 8 + wid, bl = gw / wpb, wi = gw - bl * wpb;
    if (bl >= BPS) return;
    const int b = (tok0 >> 11) + bl;
    f32x4 gv[4], lg[4], lb[4], sc[4], sh[4];
#pragma unroll
    for (int q = 0; q < 4; ++q) {
        if (MODE == 1) { gv[q] = *(const f32x4*)(gate + (size_t)b * 6144 + lane * 4 + q * 256); lg[q] = *(const f32x4*)(lng + lane * 4 + q * 256); lb[q] = *(const f32x4*)(lnb + lane * 4 + q * 256); }
        if (HOUT) { sc[q] = *(const f32x4*)(modsc + (size_t)b * 6144 + lane * 4 + q * 256) + 1.0f; sh[q] = *(const f32x4*)(modsh + (size_t)b * 6144 + lane * 4 + q * 256); } }
    for (int k0 = wi; k0 < RPB; k0 += NR * wpb) {
        f32x4 v[NR][4]; u32x2 yv[NR][4];
#pragma unroll
        for (int u = 0; u < NR; ++u) { const int rl = bl * RPB + k0 + u * wpb;
            const float* xp = xin + ((size_t)tok0 + rl) * 1024 + lane * 4;
#pragma unroll
            for (int q = 0; q < 4; ++q) v[u][q] = *(const f32x4*)(xp + q * 256);
            if (MODE == 1) { const bf16_t* yp = yin + (size_t)rl * 1024 + lane * 4;
#pragma unroll
                for (int q = 0; q < 4; ++q) yv[u][q] = *(const u32x2*)(yp + q * 256); } }
        LOADS_DONE();
#pragma unroll
        for (int u = 0; u < NR; ++u) { const int rl = bl * RPB + k0 + u * wpb;
            if (MODE == 1) {
#pragma unroll
                for (int q = 0; q < 4; ++q) v[u][q] = v[u][q] * ALPHA + gv[q] * (f32x4){bf_lo(yv[u][q].x), bf_hi(yv[u][q].x), bf_lo(yv[u][q].y), bf_hi(yv[u][q].y)}; }
            float mean, rstd; row_stats(v[u], mean, rstd);
            if (MODE == 1) {
                float* op = xout + ((size_t)tok0 + rl) * 1024 + lane * 4;
#pragma unroll
                for (int q = 0; q < 4; ++q) { v[u][q] = (v[u][q] - mean) * rstd * lg[q] + lb[q]; *(f32x4*)(op + q * 256) = v[u][q]; }
                if (HOUT) row_stats(v[u], mean, rstd);
            }
            if (HOUT) {
                bf16_t* hp = hout + (size_t)rl * 1024 + lane * 4;
#pragma unroll
                for (int q = 0; q < 4; ++q) { const f32x4 y = (v[u][q] - mean) * rstd * sc[q] + sh[q]; u32x2 w; w.x = pk2(y[0], y[1]); w.y = pk2(y[2], y[3]); *(u32x2*)(hp + q * 256) = w; }
            }
        }
    }
}

__device__ __forceinline__ void unpack8(const u32x4 w, float (&f)[8]) { f[0] = bf_lo(w.x); f[1] = bf_hi(w.x); f[2] = bf_lo(w.y); f[3] = bf_hi(w.y); f[4] = bf_lo(w.z); f[5] = bf_hi(w.z); f[6] = bf_lo(w.w); f[7] = bf_hi(w.w); }

template <int W>
__device__ __forceinline__ void pool_task(const bf16_t* __restrict__ apool, bf16_t* __restrict__ pooled, int tok0, int ch) {
    constexpr int R = 8, NR = R + W - 1;
    const int s0 = tok0 & (SEQ - 1);
    u32x4 rows[NR];
#pragma unroll
    for (int i = 0; i < NR; ++i) { const int d = i - (W - 1); rows[i] = (s0 + d >= 0) ? *(const u32x4*)(apool + ((size_t)tok0 + d) * 1024 + ch * 8) : (u32x4){0u, 0u, 0u, 0u}; }
    LOADS_DONE();
    float sum[8];
#pragma unroll
    for (int e = 0; e < 8; ++e) sum[e] = 0.f;
#pragma unroll
    for (int i = 0; i < W - 1; ++i) { float t[8]; unpack8(rows[i], t);
#pragma unroll
        for (int e = 0; e < 8; ++e) sum[e] += t[e]; }
#pragma unroll
    for (int r = 0; r < R; ++r) { float cur[8], o[8]; unpack8(rows[r + W - 1], cur);
#pragma unroll
        for (int e = 0; e < 8; ++e) sum[e] += cur[e];
        if (r > 0) { float old[8]; unpack8(rows[r - 1], old);
#pragma unroll
            for (int e = 0; e < 8; ++e) sum[e] -= old[e]; }
        const int cnt = (s0 + r + 1) < W ? (s0 + r + 1) : W; const float inv = 1.0f / (float)cnt;
#pragma unroll
        for (int e = 0; e < 8; ++e) o[e] = sum[e] * inv - cur[e];
        u32x4 wv; wv.x = pk2(o[0], o[1]); wv.y = pk2(o[2], o[3]); wv.z = pk2(o[4], o[5]); wv.w = pk2(o[6], o[7]);
        *(u32x4*)(pooled + ((size_t)tok0 + r) * 1024 + ch * 8) = wv; }
}
__device__ __forceinline__ void pool_pass(const bf16_t* apool, bf16_t* pooled, int G, int bid) {
    const int gtid = bid * 512 + tid_opaque(), gsz = G * 512;
    for (int id = gtid; id < (TS / 8) * 128; id += gsz) {
        const int g = (id >> 6) & 3, ch = g * 32 + (id & 31), run = (id >> 8) * 2 + ((id >> 5) & 1), tok0 = run * 8;
        if (g == 0) pool_task<2>(apool, pooled, tok0, ch); else if (g == 1) pool_task<4>(apool, pooled, tok0, ch); else if (g == 2) pool_task<8>(apool, pooled, tok0, ch); else pool_task<16>(apool, pooled, tok0, ch);
    }
}

__device__ __forceinline__ void norm_pass(const float* raw, bf16_t* cqn, bf16_t* k192, bf16_t* vt, const float* gq, const float* gkv, const float* cosT, const float* sinT, int tok0, LAS unsigned char* lds, int G, int bid) {
    const int tid = tid_opaque(), lane = tid & 63, wid = tid >> 6;
    LAS bf16_t* tl = (LAS bf16_t*)lds;
    const f32x4 gqv = *(const f32x4*)(gq + lane * 4); const float gk0 = gkv[2 * lane], gk1 = gkv[2 * lane + 1];
    for (int it = bid; it < TS / 64; it += G) {
        f32x4 qv[8]; float k0v[8], k1v[8], x1v[8], x2v[8], csv[8], snv[8];
#pragma unroll
        for (int jj = 0; jj < 8; ++jj) { const int tok = it * 64 + wid * 8 + jj; const float* rp = raw + (size_t)tok * 512;
            qv[jj] = *(const f32x4*)(rp + lane * 4); k0v[jj] = rp[256 + 2 * lane]; k1v[jj] = rp[256 + 2 * lane + 1];
            x1v[jj] = rp[384 + (lane & 31)]; x2v[jj] = rp[416 + (lane & 31)]; const size_t tr = (size_t)(tok0 + tok) * 32 + (lane & 31); csv[jj] = cosT[tr]; snv[jj] = sinT[tr]; }
        LOADS_DONE();
#pragma unroll
        for (int jj = 0; jj < 8; ++jj) { const int j = wid * 8 + jj, tok = it * 64 + j; const f32x4 q = qv[jj]; const float k0 = k0v[jj], k1 = k1v[jj];
            const float rq = 1.0f / sqrtf(wave_sum((q[0] * q[0] + q[1] * q[1]) + (q[2] * q[2] + q[3] * q[3])) * (1.0f / 256.0f) + RMS_EPS);
            const float rk = 1.0f / sqrtf(wave_sum(k0 * k0 + k1 * k1) * (1.0f / 128.0f) + RMS_EPS);
            u32x2 w; w.x = pk2(q[0] * rq * gqv[0], q[1] * rq * gqv[1]); w.y = pk2(q[2] * rq * gqv[2], q[3] * rq * gqv[3]); *(u32x2*)(cqn + (size_t)tok * 256 + lane * 4) = w;
            const unsigned kw = pk2(k0 * rk * gk0, k1 * rk * gk1);
            *(unsigned*)(k192 + (size_t)tok * 192 + 2 * lane) = kw; *(LAS unsigned*)(tl + j * 130 + 2 * lane) = kw;
            if (lane < 32) { const float x1 = x1v[jj], x2 = x2v[jj], cs = csv[jj], sn = snv[jj];
                k192[(size_t)tok * 192 + 128 + lane] = (bf16_t)(pk2(x1 * cs - x2 * sn, 0.f) & 0xffffu); k192[(size_t)tok * 192 + 160 + lane] = (bf16_t)(pk2(x2 * cs + x1 * sn, 0.f) & 0xffffu); } }
        __syncthreads();
        { const int d = tid >> 2, part = tid & 3, tokb = it * 64, b = tokb >> 11, s0 = (tokb & (SEQ - 1)) + part * 16; unsigned w[8];
#pragma unroll
          for (int e = 0; e < 8; ++e) { const unsigned lo = tl[(part * 16 + 2 * e) * 130 + d], hi = tl[(part * 16 + 2 * e + 1) * 130 + d]; w[e] = lo | (hi << 16); }
          bf16_t* vp = vt + ((size_t)b * 128 + d) * SEQ + s0;
          *(u32x4*)vp = (u32x4){w[0], w[1], w[2], w[3]}; *(u32x4*)(vp + 8) = (u32x4){w[4], w[5], w[6], w[7]}; }
        __syncthreads();
    }
}

__device__ __forceinline__ void sgu_pass(const bf16_t* uv, bf16_t* outp, const bf16_t* wsb, const float* bs, const float* gsg, const float* bsg, LAS unsigned char* lds, int G, int bid) {
    const int tid = tid_opaque(), lane = tid & 63, wid = tid >> 6, n = lane & 31, hh = lane >> 5;
    LAS unsigned char* vnt = lds;
    LAS float* stats = (LAS float*)(lds + 128 * 272);
    const int ch = tid & 15, half = (tid >> 4) & 1, sb = tid >> 5, s0 = sb * 8 + half * 4;
    const int tb = wid & 3, cb0 = (wid >> 2) * 2, t = tb * 32 + n, nks = 2 * (tb + 1);
    for (int it = bid; it < TS / 128; it += G) {
        const int tokb = it * 128;
#pragma unroll
        for (int hb = 0; hb < 2; ++hb) { u32x4 ra[8], rb[8];
#pragma unroll
            for (int jj = 0; jj < 8; ++jj) { const bf16_t* vp = uv + (size_t)(tokb + wid * 16 + hb * 8 + jj) * 2048 + 1024 + lane * 8; ra[jj] = *(const u32x4*)vp; rb[jj] = *(const u32x4*)(vp + 512); }
            LOADS_DONE();
#pragma unroll
            for (int jj = 0; jj < 8; ++jj) { const int j = wid * 16 + hb * 8 + jj; float a[8], b[8]; unpack8(ra[jj], a); unpack8(rb[jj], b); float s = 0.f;
#pragma unroll
                for (int e = 0; e < 8; ++e) s += a[e] + b[e];
                const float mean = wave_sum(s) * (1.0f / 1024.0f); float qq = 0.f;
#pragma unroll
                for (int e = 0; e < 8; ++e) { const float da = a[e] - mean, db = b[e] - mean; qq += da * da + db * db; }
                const float rstd = 1.0f / sqrtf(wave_sum(qq) * (1.0f / 1024.0f) + LN_EPS);
                if (lane == 0) { stats[2 * j] = mean; stats[2 * j + 1] = rstd; } } }
        u32x4 xr[4];
#pragma unroll
        for (int q = 0; q < 4; ++q) xr[q] = *(const u32x4*)(uv + (size_t)(tokb + s0 + q) * 2048 + 1024 + ch * 8);
        __syncthreads();
        for (int g = 0; g < 8; ++g) {
            { float x[4][8];
#pragma unroll
              for (int q = 0; q < 4; ++q) { unpack8(xr[q], x[q]); const float mu = stats[2 * (s0 + q)], rs = stats[2 * (s0 + q) + 1];
#pragma unroll
                  for (int e = 0; e < 8; ++e) x[q][e] = (x[q][e] - mu) * rs; }
              const f32x4 g0 = *(const f32x4*)(gsg + g * 128 + ch * 8), g1 = *(const f32x4*)(gsg + g * 128 + ch * 8 + 4), b0 = *(const f32x4*)(bsg + g * 128 + ch * 8), b1 = *(const f32x4*)(bsg + g * 128 + ch * 8 + 4);
#pragma unroll
              for (int e = 0; e < 8; ++e) { const float ge = e < 4 ? g0[e & 3] : g1[e & 3], be = e < 4 ? b0[e & 3] : b1[e & 3]; u32x2 w; w.x = pk2(x[0][e] * ge + be, x[1][e] * ge + be); w.y = pk2(x[2][e] * ge + be, x[3][e] * ge + be);
                  *(LAS u32x2*)(vnt + (ch * 8 + e) * 272 + ((sb ^ ch) * 16) + half * 8) = w; } }
            __syncthreads();
            if (g < 7) {
#pragma unroll
                for (int q = 0; q < 4; ++q) xr[q] = *(const u32x4*)(uv + (size_t)(tokb + s0 + q) * 2048 + 1024 + (g + 1) * 128 + ch * 8); }
            { f32x16 acc0, acc1;
#pragma unroll
              for (int i = 0; i < 16; ++i) { acc0[i] = 0.f; acc1[i] = 0.f; }
              const size_t tok = (size_t)(tokb + t); u32x2 uw[2][4];
#pragma unroll
              for (int cbi = 0; cbi < 2; ++cbi)
#pragma unroll
                  for (int gq = 0; gq < 4; ++gq) uw[cbi][gq] = *(const u32x2*)(uv + tok * 2048 + g * 128 + (cb0 + cbi) * 32 + 8 * gq + 4 * hh);
              const float bsv = bs[t * 8 + g];
              const bf16_t* wp = wsb + ((size_t)g * 128 + t) * 128 + 8 * hh; const int c0 = cb0 * 32 + n, c1 = c0 + 32;
              bf16x8 bfr[8];
#pragma unroll
              for (int ks = 0; ks < 8; ++ks) bfr[ks] = (ks < nks) ? *(const bf16x8*)(wp + 16 * ks) : (bf16x8){0, 0, 0, 0, 0, 0, 0, 0};
              LOADS_DONE();
#pragma unroll
              for (int ks = 0; ks < 8; ++ks) if (ks < nks) {
                  const bf16x8 a0 = *(const LAS bf16x8*)(vnt + c0 * 272 + (((2 * ks + hh) ^ (c0 >> 3)) * 16)), a1 = *(const LAS bf16x8*)(vnt + c1 * 272 + (((2 * ks + hh) ^ (c1 >> 3)) * 16));
                  acc0 = __builtin_amdgcn_mfma_f32_32x32x16_bf16(a0, bfr[ks], acc0, 0, 0, 0); acc1 = __builtin_amdgcn_mfma_f32_32x32x16_bf16(a1, bfr[ks], acc1, 0, 0, 0); }
#pragma unroll
              for (int cbi = 0; cbi < 2; ++cbi)
#pragma unroll
                  for (int gq = 0; gq < 4; ++gq) { const int cc = g * 128 + (cb0 + cbi) * 32 + 8 * gq + 4 * hh; const u32x2 u2 = uw[cbi][gq];
                      const float z0 = (cbi ? acc1[4 * gq] : acc0[4 * gq]) + bsv, z1 = (cbi ? acc1[4 * gq + 1] : acc0[4 * gq + 1]) + bsv, z2 = (cbi ? acc1[4 * gq + 2] : acc0[4 * gq + 2]) + bsv, z3 = (cbi ? acc1[4 * gq + 3] : acc0[4 * gq + 3]) + bsv;
                      u32x2 w; w.x = pk2(bf_lo(u2.x) * z0, bf_hi(u2.x) * z1); w.y = pk2(bf_lo(u2.y) * z2, bf_hi(u2.y) * z3); *(u32x2*)(outp + tok * 1024 + cc) = w; } }
            __syncthreads();
        }
    }
}

constexpr int AT_KSTR = 400, AT_VSTR = 136, AT_KBYTES = 64 * AT_KSTR, AT_VBYTES = 128 * AT_VSTR, AT_STAGE = AT_KBYTES + AT_VBYTES;
__device__ __forceinline__ void attn_phase(LAS unsigned char* lds, const bf16_t* QP, const bf16_t* K192, const bf16_t* VT, bf16_t* CTX, int G, int bid) {
    const int tid = tid_opaque(), lane = tid & 63, wid = __builtin_amdgcn_readfirstlane(tid >> 6), n = lane & 31, hh = lane >> 5;
    constexpr int NITEMS = BPS * 32 * 2;
    for (int rnd = 0; rnd * G < NITEMS; ++rnd) {
        const int j = rnd * G + ((rnd & 1) ? (G - 1 - bid) : bid);
        if (j >= NITEMS) continue;
        const int c = 31 - (j >> 5), sub = j & 31, b = sub >> 1, hq = sub & 1;
        const int h = hq * 4 + (wid & 3), qs = wid >> 2;
        const size_t tq = (size_t)b * SEQ + c * 64 + qs * 32 + n;
        bf16x8 qf[12];
        { const bf16_t* qptr = QP + tq * NQ + h * 192 + 8 * hh;
#pragma unroll
          for (int ks = 0; ks < 12; ++ks) qf[ks] = *(const bf16x8*)(qptr + 16 * ks); }
        f32x16 o[4];
#pragma unroll
        for (int db = 0; db < 4; ++db)
#pragma unroll
            for (int i = 0; i < 16; ++i) o[db][i] = 0.f;
        float m_run = -__builtin_inff(), l_run = 0.f;
        const bf16_t* kbase = K192 + (size_t)b * SEQ * 192; const bf16_t* vbase = VT + (size_t)b * 128 * SEQ;
        u32x4 kr[3], vr[2];
#define AT_LOAD(kt) do { _Pragma("unroll") for (int i = 0; i < 3; ++i) { const int id = tid + 512 * i, row = id / 24, cc = id - row * 24; kr[i] = *(const u32x4*)(kbase + (size_t)((kt) * 64 + row) * 192 + cc * 8); } \
        _Pragma("unroll") for (int i = 0; i < 2; ++i) { const int id = tid + 512 * i, d = id >> 3, cc = id & 7; vr[i] = *(const u32x4*)(vbase + (size_t)d * SEQ + (kt) * 64 + cc * 8); } } while (0)
#define AT_STORE(buf) do { LAS unsigned char* sb_ = lds + (buf) * AT_STAGE; _Pragma("unroll") for (int i = 0; i < 3; ++i) { const int id = tid + 512 * i, row = id / 24, cc = id - row * 24; *(LAS u32x4*)(sb_ + row * AT_KSTR + cc * 16) = kr[i]; } \
        _Pragma("unroll") for (int i = 0; i < 2; ++i) { const int id = tid + 512 * i, d = id >> 3, cc = id & 7; LAS unsigned char* vp_ = sb_ + AT_KBYTES + d * AT_VSTR + cc * 16; *(LAS u32x2*)vp_ = (u32x2){vr[i].x, vr[i].y}; *(LAS u32x2*)(vp_ + 8) = (u32x2){vr[i].z, vr[i].w}; } } while (0)
        AT_LOAD(0); AT_STORE(0);
        __syncthreads();
        for (int kt = 0; kt <= c; ++kt) {
            if (kt < c) AT_LOAD(kt + 1);
            LOADS_DONE();
            const LAS unsigned char* Ks = lds + (kt & 1) * AT_STAGE; const LAS unsigned char* Vs = Ks + AT_KBYTES;
            f32x16 s0, s1;
#pragma unroll
            for (int i = 0; i < 16; ++i) { s0[i] = 0.f; s1[i] = 0.f; }
            { const LAS unsigned char* ka = Ks + n * AT_KSTR + hh * 16;
#pragma unroll
              for (int ks = 0; ks < 12; ++ks) { const bf16x8 a0 = *(const LAS bf16x8*)(ka + ks * 32), a1 = *(const LAS bf16x8*)(ka + 32 * AT_KSTR + ks * 32);
                  s0 = __builtin_amdgcn_mfma_f32_32x32x16_bf16(a0, qf[ks], s0, 0, 0, 0); s1 = __builtin_amdgcn_mfma_f32_32x32x16_bf16(a1, qf[ks], s1, 0, 0, 0); } }
            float mx = s0[0];
#pragma unroll
            for (int i = 1; i < 16; ++i) mx = fmaxf(mx, s0[i]);
#pragma unroll
            for (int i = 0; i < 16; ++i) mx = fmaxf(mx, s1[i]);
            mx = fmaxf(mx, __shfl_xor(mx, 32));
            const float m_new = fmaxf(m_run, mx), alpha = __builtin_amdgcn_exp2f(m_run - m_new); m_run = m_new;
            float rs = 0.f;
#pragma unroll
            for (int i = 0; i < 16; ++i) { s0[i] = __builtin_amdgcn_exp2f(s0[i] - m_new); s1[i] = __builtin_amdgcn_exp2f(s1[i] - m_new); rs += s0[i] + s1[i]; }
            rs += __shfl_xor(rs, 32); l_run = l_run * alpha + rs;
#pragma unroll
            for (int db = 0; db < 4; ++db) o[db] *= alpha;
#pragma unroll
            for (int mb = 0; mb < 2; ++mb)
#pragma unroll
                for (int jj = 0; jj < 2; ++jj) {
                    u32x4 pw;
                    if (mb == 0) { pw.x = pk2(s0[8 * jj], s0[8 * jj + 1]); pw.y = pk2(s0[8 * jj + 2], s0[8 * jj + 3]); pw.z = pk2(s0[8 * jj + 4], s0[8 * jj + 5]); pw.w = pk2(s0[8 * jj + 6], s0[8 * jj + 7]); }
                    else { pw.x = pk2(s1[8 * jj], s1[8 * jj + 1]); pw.y = pk2(s1[8 * jj + 2], s1[8 * jj + 3]); pw.z = pk2(s1[8 * jj + 4], s1[8 * jj + 5]); pw.w = pk2(s1[8 * jj + 6], s1[8 * jj + 7]); }
                    const bf16x8 pf = __builtin_bit_cast(bf16x8, pw);
                    const LAS unsigned char* va = Vs + n * AT_VSTR + (mb * 32 + 16 * jj + 4 * hh) * 2;
#pragma unroll
                    for (int db = 0; db < 4; ++db) { const s16x4 lo = *(const LAS s16x4*)(va + db * 32 * AT_VSTR), hi = *(const LAS s16x4*)(va + db * 32 * AT_VSTR + 16);
                        const bf16x8 vf = __builtin_shufflevector(lo, hi, 0, 1, 2, 3, 4, 5, 6, 7);
                        o[db] = __builtin_amdgcn_mfma_f32_32x32x16_bf16(vf, pf, o[db], 0, 0, 0); }
                }
            if (kt < c) AT_STORE((kt + 1) & 1);
            __syncthreads();
        }
#undef AT_LOAD
#undef AT_STORE
        { const float inv = 1.0f / l_run; bf16_t* optr = CTX + tq * 1024 + h * 128 + 4 * hh;
#pragma unroll
          for (int db = 0; db < 4; ++db)
#pragma unroll
              for (int gq = 0; gq < 4; ++gq) { u32x2 w; w.x = pk2(o[db][4 * gq] * inv, o[db][4 * gq + 1] * inv); w.y = pk2(o[db][4 * gq + 2] * inv, o[db][4 * gq + 3] * inv); *(u32x2*)(optr + db * 32 + 8 * gq) = w; } }
    }
}

__device__ __forceinline__ void conv_pass(const bf16_t* __restrict__ z, bf16_t* __restrict__ ff, const float* __restrict__ cw, const float* __restrict__ cb, int G, int bid) {
    const int gtid = bid * 512 + tid_opaque(), gsz = G * 512;
    constexpr int RUN = 8, NTASK = (TS / RUN) * 352;
    for (int id = gtid; id < NTASK; id += gsz) {
        const int run = id / 352, ch = id - run * 352, uu = ch >> 4, j0 = (ch & 15) * 8, colv = 128 * uu + j0, colg = DFF + colv, tok0 = run * RUN, s0 = tok0 & (SEQ - 1);
        const bf16_t* zp = z + (size_t)tok0 * NUP + 256 * uu + j0;
        u32x4 zv[RUN + 2], zg[RUN + 2];
#pragma unroll
        for (int i = 0; i < RUN + 2; ++i) { const int d = i - 2;
            if (s0 + d >= 0) { zv[i] = *(const u32x4*)(zp + (ptrdiff_t)d * NUP); zg[i] = *(const u32x4*)(zp + (ptrdiff_t)d * NUP + 128); } else { zv[i] = (u32x4){0u, 0u, 0u, 0u}; zg[i] = (u32x4){0u, 0u, 0u, 0u}; } }
        float wv[3][8], wg[3][8], bv[8], bg[8];
#pragma unroll
        for (int k = 0; k < 3; ++k) { const f32x4 a = *(const f32x4*)(cw + k * NUP + colv), b = *(const f32x4*)(cw + k * NUP + colv + 4), c = *(const f32x4*)(cw + k * NUP + colg), d = *(const f32x4*)(cw + k * NUP + colg + 4);
#pragma unroll
            for (int e = 0; e < 4; ++e) { wv[k][e] = a[e]; wv[k][4 + e] = b[e]; wg[k][e] = c[e]; wg[k][4 + e] = d[e]; } }
        { const f32x4 a = *(const f32x4*)(cb + colv), b = *(const f32x4*)(cb + colv + 4), c = *(const f32x4*)(cb + colg), d = *(const f32x4*)(cb + colg + 4);
#pragma unroll
          for (int e = 0; e < 4; ++e) { bv[e] = a[e]; bv[4 + e] = b[e]; bg[e] = c[e]; bg[4 + e] = d[e]; } }
        LOADS_DONE();
        float v2[8], v1[8], g2[8], g1[8];
        unpack8(zv[0], v2); unpack8(zv[1], v1); unpack8(zg[0], g2); unpack8(zg[1], g1);
#pragma unroll
        for (int r = 0; r < RUN; ++r) { float v0[8], g0[8], o[8]; unpack8(zv[r + 2], v0); unpack8(zg[r + 2], g0);
#pragma unroll
            for (int e = 0; e < 8; ++e) { const float vc = bv[e] + wv[0][e] * v2[e] + wv[1][e] * v1[e] + wv[2][e] * v0[e], gc = bg[e] + wg[0][e] * g2[e] + wg[1][e] * g1[e] + wg[2][e] * g0[e];
                o[e] = gc * pg8::sigm(gc) * vc; v2[e] = v1[e]; v1[e] = v0[e]; g2[e] = g1[e]; g1[e] = g0[e]; }
            u32x4 w; w.x = pk2(o[0], o[1]); w.y = pk2(o[2], o[3]); w.z = pk2(o[4], o[5]); w.w = pk2(o[6], o[7]);
            *(u32x4*)(ff + (size_t)(tok0 + r) * DFF + colv) = w; }
    }
}

__device__ __forceinline__ void conv_fix(const float* __restrict__ zb, bf16_t* __restrict__ ff, const float* __restrict__ cw, const float* __restrict__ cb, int G, int bid) {
    const int gtid = bid * 512 + tid_opaque(), gsz = G * 512;
    for (int id = gtid; id < (TS / 64) * 352; id += gsz) {
        const int gi = id / 352, ch = id - gi * 352, uu = ch >> 4, j0 = (ch & 15) * 8, colv = 128 * uu + j0, colg = DFF + colv, zc = 256 * uu + j0;
        const bool hasprev = (gi & 31) != 0;
        float zv[4][8], zg[4][8];
#pragma unroll
        for (int r = 0; r < 4; ++r) {
            const float* zp = zb + ((size_t)(r < 2 ? gi - 1 : gi) * 4 + (r < 2 ? 2 + r : r - 2)) * NUP + zc;
            if (r >= 2 || hasprev) { const f32x4 a = *(const f32x4*)zp, b = *(const f32x4*)(zp + 4), c = *(const f32x4*)(zp + 128), d = *(const f32x4*)(zp + 132);
#pragma unroll
                for (int e = 0; e < 4; ++e) { zv[r][e] = a[e]; zv[r][4 + e] = b[e]; zg[r][e] = c[e]; zg[r][4 + e] = d[e]; } }
            else {
#pragma unroll
                for (int e = 0; e < 8; ++e) { zv[r][e] = 0.f; zg[r][e] = 0.f; } } }
        float wv[3][8], wg[3][8], bv[8], bg[8];
#pragma unroll
        for (int k = 0; k < 3; ++k) { const f32x4 a = *(const f32x4*)(cw + k * NUP + colv), b = *(const f32x4*)(cw + k * NUP + colv + 4), c = *(const f32x4*)(cw + k * NUP + colg), d = *(const f32x4*)(cw + k * NUP + colg + 4);
#pragma unroll
            for (int e = 0; e < 4; ++e) { wv[k][e] = a[e]; wv[k][4 + e] = b[e]; wg[k][e] = c[e]; wg[k][4 + e] = d[e]; } }
        { const f32x4 a = *(const f32x4*)(cb + colv), b = *(const f32x4*)(cb + colv + 4), c = *(const f32x4*)(cb + colg), d = *(const f32x4*)(cb + colg + 4);
#pragma unroll
          for (int e = 0; e < 4; ++e) { bv[e] = a[e]; bv[4 + e] = b[e]; bg[e] = c[e]; bg[4 + e] = d[e]; } }
        LOADS_DONE();
#pragma unroll
        for (int r = 0; r < 2; ++r) { float o[8];
#pragma unroll
            for (int e = 0; e < 8; ++e) { const float vc = bv[e] + wv[0][e] * zv[r][e] + wv[1][e] * zv[r + 1][e] + wv[2][e] * zv[r + 2][e], gc = bg[e] + wg[0][e] * zg[r][e] + wg[1][e] * zg[r + 1][e] + wg[2][e] * zg[r + 2][e];
                o[e] = gc * pg8::sigm(gc) * vc; }
            u32x4 w; w.x = pk2(o[0], o[1]); w.y = pk2(o[2], o[3]); w.z = pk2(o[4], o[5]); w.w = pk2(o[6], o[7]);
            *(u32x4*)(ff + (size_t)(gi * 64 + r) * DFF + colv) = w; }
    }
}

__global__ void __launch_bounds__(512, 2) mega_fwd(Params p_unused) {
    extern __shared__ __attribute__((aligned(16))) unsigned char lds_raw[];
    LAS unsigned char* lds = (LAS unsigned char*)lds_raw;
    cg::grid_group grid = cg::this_grid();
    (void)p_unused;
    if (threadIdx.x < 2) ((LAS unsigned*)(lds + LDS_BARST))[threadIdx.x] = 0u;
    __syncthreads();
    { KPtr p0 = kparams(); (void)xcd_barrier_post((unsigned*)(p0->ws + OFF_BAR), (volatile LAS unsigned*)(lds + LDS_BARST)); }
#define GSYNC() do { KPtr pb_ = kparams(); XcdBarrier xb_; xb_.bar = (unsigned*)(pb_->ws + OFF_BAR); xb_.x = xb_xcc_id(); xb_.st = (volatile LAS unsigned*)(lds + LDS_BARST); xcd_barrier(xb_); } while (0)
#ifdef PROBE_MASK
    unsigned long long t_prev = __builtin_amdgcn_s_memrealtime(), t_acc = 0ull;
#define STAMP(cls) do { const unsigned long long t_ = __builtin_amdgcn_s_memrealtime(); if ((PROBE_MASK >> (cls)) & 1) t_acc += t_ - t_prev; t_prev = t_; } while (0)
#else
#define STAMP(cls) do { } while (0)
#endif
#define PH_BEGIN KPtr p = kparams(); int G = (int)gridDim.x, bid = (int)blockIdx.x; asm volatile("" : "+s"(G), "+s"(bid)); unsigned char* ws = p->ws; (void)ws;
    { PH_BEGIN prep_phase(p, lds, G, bid); }
    grid.sync(); STAMP(0);
    for (int sl = 0; sl < NS; ++sl) {
        const int tok0 = sl * TS;
        { PH_BEGIN const float* MOD = (const float*)(ws + OFF_MOD);
          ln_pass<0, true>(p->x, nullptr, nullptr, nullptr, (bf16_t*)(ws + OFF_H), tok0, nullptr, nullptr, MOD + 0, MOD + 1024, G, bid); }
        GSYNC(); STAMP(7);
        for (int l = 0; l < 2; ++l) {
            { PH_BEGIN const unsigned char* wl = ws + OFF_WL + (size_t)l * WL_STRIDE;
              pg8::Gemm g{(const bf16_t*)(ws + OFF_H), (const bf16_t*)(wl + WO_W1), TS, N1, 1024}; pg8::StaticOrder S; S.init(TS, N1, G, bid);
              pg8::Epi1 E{(bf16_t*)(ws + OFF_GATES), (bf16_t*)(ws + OFF_APOOL), (bf16_t*)(ws + OFF_UV), (float*)(ws + OFF_RAW)};
              pg8::gemm_phase<pg8::Epi1, pg8::StaticOrder, true, true>(lds, g, S, E); }
            GSYNC(); STAMP(1);
            { PH_BEGIN pool_pass((const bf16_t*)(ws + OFF_APOOL), (bf16_t*)(ws + OFF_BR), G, bid); }
            { PH_BEGIN
              norm_pass((const float*)(ws + OFF_RAW), (bf16_t*)(ws + OFF_CQN), (bf16_t*)(ws + OFF_K192), (bf16_t*)(ws + OFF_VT), p->g_q + l * 256, p->g_kv + l * 128, (const float*)(ws + OFF_COS), (const float*)(ws + OFF_SIN), tok0, lds, G, bid); }
            { PH_BEGIN
              sgu_pass((const bf16_t*)(ws + OFF_UV), (bf16_t*)(ws + OFF_BR) + (size_t)2 * TS * 1024, (const bf16_t*)(ws + OFF_WSB) + (size_t)l * 8 * 128 * 128, p->b_s + l * 1024, p->g_sg + l * 1024, p->b_sg + l * 1024, lds, G, bid); }
            GSYNC(); STAMP(2);
            { PH_BEGIN const unsigned char* wl = ws + OFF_WL + (size_t)l * WL_STRIDE;
              int kq = 256; asm volatile("" : "+s"(kq));
              pg8::Gemm g{(const bf16_t*)(ws + OFF_CQN), (const bf16_t*)(wl + WO_WQ), TS, NQ, kq}; pg8::StaticOrder S; S.init(TS, NQ, G, bid);
              pg8::EpiQ E{(bf16_t*)(ws + OFF_QP), (const float*)(ws + OFF_COS), (const float*)(ws + OFF_SIN), tok0};
              pg8::gemm_phase<pg8::EpiQ, pg8::StaticOrder, true, true>(lds, g, S, E); }
            GSYNC(); STAMP(3);
            { PH_BEGIN
              attn_phase(lds, (const bf16_t*)(ws + OFF_QP), (const bf16_t*)(ws + OFF_K192), (const bf16_t*)(ws + OFF_VT), (bf16_t*)(ws + OFF_BR) + (size_t)TS * 1024, G, bid); }
            GSYNC(); STAMP(4);
            { PH_BEGIN const unsigned char* wl = ws + OFF_WL + (size_t)l * WL_STRIDE;
              pg8::Gemm g{(const bf16_t*)(ws + OFF_BR), (const bf16_t*)(wl + WO_WBR), 3 * TS, 3 * 1024, 1024}; pg8::BrOrder S; S.init(TS, G, bid);
              pg8::EpiBr E{(const bf16_t*)(ws + OFF_GATES), (float*)(ws + OFF_PART), (bf16_t*)(ws + OFF_H), TS / 256};
              pg8::gemm_phase<pg8::EpiBr, pg8::BrOrder, true, true>(lds, g, S, E); }
            GSYNC(); STAMP(5);
            { PH_BEGIN const unsigned char* wl = ws + OFF_WL + (size_t)l * WL_STRIDE;
              pg8::Gemm g{(const bf16_t*)(ws + OFF_H), (const bf16_t*)(wl + WO_WO), TS, 1024, 1024}; pg8::StaticOrder S; S.init(TS, 1024, G, bid);
              pg8::EpiUp E{(bf16_t*)(ws + OFF_Y), 1024};
              pg8::gemm_phase<pg8::EpiUp, pg8::StaticOrder, true, true>(lds, g, S, E); }
            GSYNC(); STAMP(6);
            { PH_BEGIN const float* modl = (const float*)(ws + OFF_MOD) + (size_t)l * 32 * 6144;
              ln_pass<1, true>((l == 0) ? p->x : (const float*)p->out, (const bf16_t*)(ws + OFF_Y), modl + 2048, p->out, (bf16_t*)(ws + OFF_H), tok0, p->ln_t_g + l * 1024, p->ln_t_b + l * 1024, modl + 3072, modl + 4096, G, bid); }
            GSYNC(); STAMP(7);
            { PH_BEGIN const unsigned char* wl = ws + OFF_WL + (size_t)l * WL_STRIDE;
              pg8::Gemm g{(const bf16_t*)(ws + OFF_H), (const bf16_t*)(wl + WO_WUP), TS, NUP, 1024}; pg8::StaticOrder S; S.init(TS, NUP, G, bid);
              pg8::EpiUpConv E{(bf16_t*)(ws + OFF_FF), (float*)(ws + OFF_Z), p->conv_w + (size_t)l * 3 * NUP, p->conv_b + (size_t)l * NUP};
              pg8::gemm_phase<pg8::EpiUpConv, pg8::StaticOrder, true, true>(lds, g, S, E); }
            GSYNC(); STAMP(8);
            { PH_BEGIN conv_fix((const float*)(ws + OFF_Z), (bf16_t*)(ws + OFF_FF), p->conv_w + (size_t)l * 3 * NUP, p->conv_b + (size_t)l * NUP, G, bid); }
            GSYNC(); STAMP(9);
            { PH_BEGIN const unsigned char* wl = ws + OFF_WL + (size_t)l * WL_STRIDE;
              pg8::Gemm g{(const bf16_t*)(ws + OFF_FF), (const bf16_t*)(wl + WO_WDN), TS, 1024, DFF}; pg8::StaticOrder S; S.init(TS, 1024, G, bid); pg8::EpiUp E{(bf16_t*)(ws + OFF_Y), 1024};
              pg8::gemm_phase<pg8::EpiUp, pg8::StaticOrder, true, true>(lds, g, S, E); }
            GSYNC(); STAMP(10);
            { PH_BEGIN const float* modl = (const float*)(ws + OFF_MOD) + (size_t)l * 32 * 6144; const float* mod1 = (const float*)(ws + OFF_MOD) + (size_t)32 * 6144;
              if (l == 0) ln_pass<1, true>(p->out, (const bf16_t*)(ws + OFF_Y), modl + 5120, p->out, (bf16_t*)(ws + OFF_H), tok0, p->ln_f_g, p->ln_f_b, mod1, mod1 + 1024, G, bid);
              else ln_pass<1, false>(p->out, (const bf16_t*)(ws + OFF_Y), modl + 5120, p->out, nullptr, tok0, p->ln_f_g + 1024, p->ln_f_b + 1024, nullptr, nullptr, G, bid); }
            GSYNC(); STAMP(7);
        }
    }
#ifdef PROBE_MASK
    { PH_BEGIN (void)G; if (bid == 0) { unsigned long long us = t_acc / 100ull; if (us > 20000ull) us = 20000ull; for (int i = tid_opaque(); i < (int)us; i += 512) p->out[i] += 0.1f; } }
#endif
}

extern "C" void kernel_launch(void* const* d_in, const int* in_sizes, int n_in, void* d_out, int out_size, void* d_ws, size_t ws_size, hipStream_t stream) {
    static int grid = 0;
    if (grid == 0) {
        if (n_in != 26 || ws_size < WS_NEED) { fprintf(stderr, "kernel_launch: unexpected n_in %d / ws_size %zu\n", n_in, ws_size); grid = -1; return; }
        int dev = 0, cus = 0, per_cu = 0;
        if (hipGetDevice(&dev) != hipSuccess || hipDeviceGetAttribute(&cus, hipDeviceAttributeMultiprocessorCount, dev) != hipSuccess) { grid = -1; return; }
        if (hipFuncSetAttribute((const void*)mega_fwd, hipFuncAttributeMaxDynamicSharedMemorySize, LDS_BYTES) != hipSuccess) { fprintf(stderr, "kernel_launch: hipFuncSetAttribute failed\n"); grid = -1; return; }
        if (hipOccupancyMaxActiveBlocksPerMultiprocessor(&per_cu, (const void*)mega_fwd, 512, LDS_BYTES) != hipSuccess || per_cu < 1) { fprintf(stderr, "kernel_launch: occupancy query says %d\n", per_cu); per_cu = 1; }
        (void)hipGetLastError();
        grid = cus;
    }
    if (grid < 0) return;
    Params p{};
    const float** pf = (const float**)&p;
    p.x = (const float*)d_in[0]; p.c = (const float*)d_in[1]; p.pos = (const int*)d_in[2]; p.w_ada = (const float*)d_in[3]; p.b_ada = (const float*)d_in[4]; p.w_in = (const float*)d_in[5];
    p.w_pool = (const float*)d_in[6]; p.s_pool = (const float*)d_in[7]; p.g_q = (const float*)d_in[8]; p.w_uq = (const float*)d_in[9]; p.g_kv = (const float*)d_in[10]; p.w_ukv = (const float*)d_in[11];
    p.g_sg = (const float*)d_in[12]; p.b_sg = (const float*)d_in[13]; p.w_s = (const float*)d_in[14]; p.b_s = (const float*)d_in[15]; p.w_branch = (const float*)d_in[16]; p.w_o = (const float*)d_in[17];
    p.ln_t_g = (const float*)d_in[18]; p.ln_t_b = (const float*)d_in[19]; p.w_up = (const float*)d_in[20]; p.conv_w = (const float*)d_in[21]; p.conv_b = (const float*)d_in[22]; p.w_down = (const float*)d_in[23];
    p.ln_f_g = (const float*)d_in[24]; p.ln_f_b = (const float*)d_in[25];
    (void)pf;
    p.out = (float*)d_out; p.ws = (unsigned char*)d_ws;
    if (hipMemsetAsync((unsigned char*)d_ws + OFF_BAR, 0, BAR_BYTES, stream) != hipSuccess) { fprintf(stderr, "kernel_launch: memset failed\n"); return; }
    void* args[] = {&p};
    const hipError_t e = hipLaunchCooperativeKernel((const void*)mega_fwd, dim3(grid), dim3(512), args, LDS_BYTES, stream);
    if (e != hipSuccess) fprintf(stderr, "kernel_launch: cooperative launch failed: %s (grid %d)\n", hipGetErrorString(e), grid);
}
```

```cpp
#include <hip/hip_runtime.h>
#include <hip/hip_cooperative_groups.h>
#include <cstdio>
#include <cstdint>
namespace cg = cooperative_groups;
namespace pg8 {
#define PG8_LAS __attribute__((address_space(3)))
typedef unsigned short bf16_t;
typedef short bf16x8 __attribute__((ext_vector_type(8)));
typedef float f32x4 __attribute__((ext_vector_type(4)));
typedef unsigned u32x4 __attribute__((ext_vector_type(4)));
constexpr int BM = 256, BK = 64, HALF = 128, HTB = HALF * BK * 2  , STAGE_BYTES = 8 * HTB, NXCD = 8, WGM = 8;

__host__ __device__ __forceinline__ int lds_byte(int r, int c) { const int st = (r >> 4) * 2 + (c >> 5), rr = r & 15, cc = c & 31, ob = rr * 64 + cc * 2; return st * 1024 + (ob ^ (((ob >> 9) & 1) << 5)); }
__host__ __device__ __forceinline__ void stage_rc(int b, int& R, int& C) { const int st = b / 1024, sb = b % 1024, swz = sb ^ (((sb >> 9) & 1) << 5); R = (st >> 1) * 16 + swz / 64; C = (st & 1) * 32 + (swz % 64) / 2; }
__host__ __device__ __forceinline__ int perm32(int rho) { const int n = rho >> 4, i = rho & 15; return 8 * (i >> 2) + 4 * n + (i & 3); }

struct Unit { int pm, pn; };
struct Gemm { const bf16_t* A; const bf16_t* Bt; int M, N, K; };

struct StaticOrder {
    int nM, nN, nwg, G, c;
    __host__ __device__ void init(int M, int N, int G_, int c_) { nM = M / BM; nN = N / BM; nwg = nM * nN; G = G_; c = c_; }
    __host__ __device__ bool next(int i, Unit& u) const {
        const long L = (long)i * G + c; if (L >= nwg) return false;
        int wgid = (int)L; { const int q = nwg / NXCD, r = nwg % NXCD, xcd = wgid % NXCD, off = wgid / NXCD; wgid = (xcd < r ? xcd * (q + 1) : r * (q + 1) + (xcd - r) * q) + off; }
        const int nig = WGM * nN, gid = wgid / nig, fm = gid * WGM, gsz = (nM - fm) < WGM ? (nM - fm) : WGM;
        u.pm = fm + ((wgid % nig) % gsz); u.pn = (wgid % nig) / gsz; return true;
    }
    __device__ __forceinline__ void a_ready(const Unit&) const {}
    __device__ __forceinline__ void done(const Unit&) const {}
};


typedef float f32x2 __attribute__((ext_vector_type(2)));
typedef __bf16 bfv2 __attribute__((ext_vector_type(2)));
typedef unsigned u32x2 __attribute__((ext_vector_type(2)));
__device__ __forceinline__ unsigned pk2(float a, float b) { f32x2 v = {a, b}; bfv2 r = __builtin_convertvector(v, bfv2); return __builtin_bit_cast(unsigned, r); }
__device__ __forceinline__ float bf_lo(unsigned w) { return __uint_as_float(w << 16); }
__device__ __forceinline__ float bf_hi(unsigned w) { return __uint_as_float(w & 0xffff0000u); }
__device__ __forceinline__ u32x4 pack8(const f32x4 a, const f32x4 b) { u32x4 w; w.x = pk2(a[0], a[1]); w.y = pk2(a[2], a[3]); w.z = pk2(b[0], b[1]); w.w = pk2(b[2], b[3]); return w; }
__device__ __forceinline__ f32x2 gelu_pk(f32x2 v) {
    const f32x2 av = __builtin_elementwise_abs(v), d = av * 0.2316418882f + 1.0f;
    f32x2 t; t.x = __builtin_amdgcn_rcpf(d.x); t.y = __builtin_amdgcn_rcpf(d.y);
    f32x2 q = t * 0.5307027145f + (-0.7265760135f); q = q * t + 0.7107068705f; q = q * t + (-0.142248368f); q = q * t + 0.127414796f; q = q * t;
    const f32x2 s = (v * v) * (-0.72134752044f);
    f32x2 e; e.x = __builtin_amdgcn_exp2f(s.x); e.y = __builtin_amdgcn_exp2f(s.y);
    const f32x2 m = v * (q * e), r = v - m;
    f32x2 o; o.x = v.x < 0.f ? m.x : r.x; o.y = v.y < 0.f ? m.y : r.y; return o;
}
__device__ __forceinline__ f32x4 gelu4(f32x4 v) { const f32x2 a = gelu_pk((f32x2){v[0], v[1]}), b = gelu_pk((f32x2){v[2], v[3]}); return (f32x4){a.x, a.y, b.x, b.y}; }
__device__ __forceinline__ float sigm(float x) { return __builtin_amdgcn_rcpf(1.0f + __builtin_amdgcn_exp2f(-1.4426950408889634f * x)); }
__device__ __forceinline__ f32x4 sigm4(f32x4 v) { return (f32x4){sigm(v[0]), sigm(v[1]), sigm(v[2]), sigm(v[3])}; }

struct Epi1 {
    static constexpr bool PERM = true, AFTER_DRAIN = false;
    __device__ __forceinline__ bool zero_after(const Unit&) const { return true; }
    bf16_t* gates; bf16_t* apool; bf16_t* uv; float* raw;
    __device__ __forceinline__ void operator()(const f32x4 (&acc)[2][2][4][2], const Unit& u, int wr, int wc, int fr, int fq) const {
        const int row0 = u.pm * BM + wr * 64 + fr, cl = wc * 32 + 8 * fq, pn = u.pn;
        if (pn < 24) {
            bf16_t* base; int ldc, col0, act;
            if (pn < 12) { base = gates; ldc = 3072; col0 = pn * 256; act = 1; }
            else if (pn < 16) { base = apool; ldc = 1024; col0 = (pn - 12) * 256; act = 0; }
            else { base = uv; ldc = 2048; col0 = (pn - 16) * 256; act = 2; }
#pragma unroll
            for (int ai = 0; ai < 2; ++ai)
#pragma unroll
                for (int m = 0; m < 4; ++m) { bf16_t* rowp = base + (size_t)(row0 + ai * HALF + m * 16) * ldc + col0 + cl;
#pragma unroll
                    for (int bj = 0; bj < 2; ++bj) { f32x4 v0 = acc[ai][bj][m][0], v1 = acc[ai][bj][m][1];
                        if (act == 1) { v0 = sigm4(v0); v1 = sigm4(v1); }
                        else if (act == 2) { v0 = gelu4(v0); v1 = gelu4(v1); }
                        *(u32x4*)(rowp + bj * HALF) = pack8(v0, v1); } }
        } else {
            float* base = raw + (pn - 24) * 256 + cl;
#pragma unroll
            for (int ai = 0; ai < 2; ++ai)
#pragma unroll
                for (int m = 0; m < 4; ++m) { float* rowp = base + (size_t)(row0 + ai * HALF + m * 16) * 512;
#pragma unroll
                    for (int bj = 0; bj < 2; ++bj) { *(f32x4*)(rowp + bj * HALF) = acc[ai][bj][m][0]; *(f32x4*)(rowp + bj * HALF + 4) = acc[ai][bj][m][1]; } }
        }
    }
};
struct EpiQ {
    static constexpr bool PERM = true, AFTER_DRAIN = false;
    __device__ __forceinline__ bool zero_after(const Unit&) const { return true; }
    bf16_t* qp; const float* cosT; const float* sinT; int tok0;
    __device__ __forceinline__ void operator()(const f32x4 (&acc)[2][2][4][2], const Unit& u, int wr, int wc, int fr, int fq) const {
        const float SC = 0.10411754627697264f;
        const int row0 = u.pm * BM + wr * 64 + fr;
        if (u.pn < 4) {
#pragma unroll
            for (int ai = 0; ai < 2; ++ai)
#pragma unroll
                for (int m = 0; m < 4; ++m) { bf16_t* rowp = qp + (size_t)(row0 + ai * HALF + m * 16) * 1536 + wc * 32 + 8 * fq;
#pragma unroll
                    for (int bj = 0; bj < 2; ++bj) *(u32x4*)(rowp + (2 * u.pn + bj) * 192) = pack8(acc[ai][bj][m][0] * SC, acc[ai][bj][m][1] * SC); }
        } else {
            const int h = 4 * (u.pn - 4) + wc;
#pragma unroll
            for (int ai = 0; ai < 2; ++ai)
#pragma unroll
                for (int m = 0; m < 4; ++m) { const int row = row0 + ai * HALF + m * 16;
#pragma unroll
                    for (int n = 0; n < 2; ++n) { const int i0 = 8 * fq + 4 * n; const size_t tr = (size_t)(tok0 + row) * 32 + i0;
                        const f32x4 c0 = *(const f32x4*)(cosT + tr) * SC, s0 = *(const f32x4*)(sinT + tr) * SC, x1 = acc[ai][0][m][n], x2 = acc[ai][1][m][n];
                        const f32x4 o1 = x1 * c0 - x2 * s0, o2 = x2 * c0 + x1 * s0;
                        bf16_t* rowp = qp + (size_t)row * 1536 + h * 192 + 128 + i0;
                        u32x2 w1; w1.x = pk2(o1[0], o1[1]); w1.y = pk2(o1[2], o1[3]); u32x2 w2; w2.x = pk2(o2[0], o2[1]); w2.y = pk2(o2[2], o2[3]);
                        *(u32x2*)(rowp) = w1; *(u32x2*)(rowp + 32) = w2; }
                    asm volatile("" ::: "memory"); }
        }
    }
};
struct EpiBr {
    static constexpr bool PERM = true;
    static constexpr bool AFTER_DRAIN = false;
    const bf16_t* gates; bf16_t* merged; int nM;
    __device__ __forceinline__ bool zero_after(const Unit& u) const { return (u.pn >> 2) == 2; }
    __device__ __forceinline__ void operator()(f32x4 (&acc)[2][2][4][2], const Unit& u, int wr, int wc, int fr, int fq) const {
        const int br = u.pn >> 2, pn = u.pn & 3, pm = u.pm - br * nM;
        const int row0 = pm * BM + wr * 64 + fr, cl = pn * 256 + wc * 32 + 8 * fq;
#pragma unroll
        for (int ai = 0; ai < 2; ++ai)
#pragma unroll
            for (int mp = 0; mp < 2; ++mp) {
                u32x4 gc[2][2], gn[2][2];
#pragma unroll
                for (int mm = 0; mm < 2; ++mm) { const size_t row = (size_t)(row0 + ai * HALF + (2 * mp + mm) * 16);
#pragma unroll
                    for (int bj = 0; bj < 2; ++bj) { const bf16_t* gp = gates + row * 3072 + br * 1024 + cl + bj * HALF; gc[mm][bj] = *(const u32x4*)gp; if (br != 2) gn[mm][bj] = *(const u32x4*)(gp + 1024); } }
                asm volatile("" ::: "memory"); __builtin_amdgcn_sched_barrier(0);
#pragma unroll
                for (int mm = 0; mm < 2; ++mm) { const int m = 2 * mp + mm; const size_t row = (size_t)(row0 + ai * HALF + m * 16);
#pragma unroll
                    for (int bj = 0; bj < 2; ++bj) { const u32x4 g = gc[mm][bj];
                        f32x4 f0 = {bf_lo(g.x), bf_hi(g.x), bf_lo(g.y), bf_hi(g.y)}, f1 = {bf_lo(g.z), bf_hi(g.z), bf_lo(g.w), bf_hi(g.w)};
                        if (br != 0) {
#pragma unroll
                            for (int j = 0; j < 4; ++j) { f0[j] = fmaxf(f0[j], 1e-30f); f1[j] = fmaxf(f1[j], 1e-30f); } }
                        if (br != 2) { const u32x4 h = gn[mm][bj];
                            const f32x4 n0 = {bf_lo(h.x), bf_hi(h.x), bf_lo(h.y), bf_hi(h.y)}, n1 = {bf_lo(h.z), bf_hi(h.z), bf_lo(h.w), bf_hi(h.w)};
#pragma unroll
                            for (int j = 0; j < 4; ++j) { f0[j] *= __builtin_amdgcn_rcpf(fmaxf(n0[j], 1e-30f)); f1[j] *= __builtin_amdgcn_rcpf(fmaxf(n1[j], 1e-30f)); }
                            acc[ai][bj][m][0] *= f0; acc[ai][bj][m][1] *= f1; }
                        else *(u32x4*)(merged + row * 1024 + cl + bj * HALF) = pack8(acc[ai][bj][m][0] * f0, acc[ai][bj][m][1] * f1); } }
            }
    }
};
struct EpiRes {
    static constexpr bool PERM = false, AFTER_DRAIN = false;
    __device__ __forceinline__ bool zero_after(const Unit&) const { return true; }
    const float* xin; float* xout; const float* gate; int tok0;
    __device__ __forceinline__ void operator()(const f32x4 (&acc)[2][2][4][2], const Unit& u, int wr, int wc, int fr, int fq) const {
        const float ALPHA = 1.4142135623730951f;
        const int grow0 = tok0 + u.pm * BM + wr * 64 + fr, col0 = u.pn * BM + wc * 32 + 4 * fq;
        const float* gp = gate + (size_t)((tok0 + u.pm * BM) >> 11) * 6144 + col0;
        f32x4 gv[2][2];
#pragma unroll
        for (int bj = 0; bj < 2; ++bj)
#pragma unroll
            for (int n = 0; n < 2; ++n) gv[bj][n] = *(const f32x4*)(gp + bj * HALF + n * 16);
#pragma unroll
        for (int ai = 0; ai < 2; ++ai)
#pragma unroll
            for (int m = 0; m < 4; ++m) { const size_t off = (size_t)(grow0 + ai * HALF + m * 16) * 1024 + col0;
#pragma unroll
                for (int bj = 0; bj < 2; ++bj)
#pragma unroll
                    for (int n = 0; n < 2; ++n) { const f32x4 xv = *(const f32x4*)(xin + off + bj * HALF + n * 16); *(f32x4*)(xout + off + bj * HALF + n * 16) = xv * ALPHA + gv[bj][n] * acc[ai][bj][m][n]; } }
    }
};
struct EpiUp {
    static constexpr bool PERM = true, AFTER_DRAIN = false;
    __device__ __forceinline__ bool zero_after(const Unit&) const { return true; }
    bf16_t* z; int ldc;
    __device__ __forceinline__ void operator()(const f32x4 (&acc)[2][2][4][2], const Unit& u, int wr, int wc, int fr, int fq) const {
        const int row0 = u.pm * BM + wr * 64 + fr, col0 = u.pn * BM + wc * 32 + 8 * fq;
#pragma unroll
        for (int ai = 0; ai < 2; ++ai)
#pragma unroll
            for (int m = 0; m < 4; ++m) { bf16_t* rowp = z + (size_t)(row0 + ai * HALF + m * 16) * ldc + col0;
#pragma unroll
                for (int bj = 0; bj < 2; ++bj) *(u32x4*)(rowp + bj * HALF) = pack8(acc[ai][bj][m][0], acc[ai][bj][m][1]); }
    }
};
__device__ __forceinline__ f32x4 dpp_ror(const f32x4 v, const int n) {
    f32x4 r;
#pragma unroll
    for (int j = 0; j < 4; ++j) { const float e = v[j]; const int x = __float_as_int(e); const int y = (n == 1) ? __builtin_amdgcn_update_dpp(0, x, 0x121, 0xF, 0xF, false) : __builtin_amdgcn_update_dpp(0, x, 0x122, 0xF, 0xF, false); r[j] = __int_as_float(y); }
    return r;
}
struct EpiUpConv {
    static constexpr bool PERM = true, AFTER_DRAIN = false;
    __device__ __forceinline__ bool zero_after(const Unit&) const { return true; }
    bf16_t* ff; float* zb; const float* cw; const float* cb;
    __device__ __forceinline__ void operator()(const f32x4 (&acc)[2][2][4][2], const Unit& u, int wr, int wc, int fr, int fq) const {
        const int cofs = 32 * wc + 8 * fq, colv0 = 128 * u.pn + cofs, zcol0 = 256 * u.pn + cofs;
        const bool f0 = (fr == 0), f01 = (fr < 2);
#pragma unroll
        for (int ai = 0; ai < 2; ++ai) {
            const int rowbase = u.pm * BM + ai * HALF + wr * 64, gi = rowbase >> 6;
#pragma unroll
            for (int n = 0; n < 2; ++n) {
                const float* pv = cw + colv0 + 4 * n; const float* pg = pv + 2816;
                const f32x4 wv0 = *(const f32x4*)pv, wv1 = *(const f32x4*)(pv + 5632), wv2 = *(const f32x4*)(pv + 2 * 5632), bv = *(const f32x4*)(cb + colv0 + 4 * n);
                const f32x4 wg0 = *(const f32x4*)pg, wg1 = *(const f32x4*)(pg + 5632), wg2 = *(const f32x4*)(pg + 2 * 5632), bg = *(const f32x4*)(cb + 2816 + colv0 + 4 * n);
                f32x4 p1v = {0.f, 0.f, 0.f, 0.f}, p2v = p1v, p1g = p1v, p2g = p1v;
#pragma unroll
                for (int m = 0; m < 4; ++m) { const f32x4 zv = acc[ai][0][m][n], zg = acc[ai][1][m][n];
                    const f32x4 t1v = dpp_ror(zv, 1), t2v = dpp_ror(zv, 2), t1g = dpp_ror(zg, 1), t2g = dpp_ror(zg, 2);
                    f32x4 vc = bv + wv2 * zv, gc = bg + wg2 * zg;
#pragma unroll
                    for (int j = 0; j < 4; ++j) { vc[j] += wv1[j] * (f0 ? p1v[j] : t1v[j]) + wv0[j] * (f01 ? p2v[j] : t2v[j]); gc[j] += wg1[j] * (f0 ? p1g[j] : t1g[j]) + wg0[j] * (f01 ? p2g[j] : t2g[j]); }
                    const f32x4 o = gc * sigm4(gc) * vc;
                    if (m > 0 || !f01) { u32x2 w; w.x = pk2(o[0], o[1]); w.y = pk2(o[2], o[3]); *(u32x2*)(ff + (size_t)(rowbase + 16 * m + fr) * 2816 + colv0 + 4 * n) = w; }
                    p1v = t1v; p2v = t2v; p1g = t1g; p2g = t2g; }
                asm volatile("" ::: "memory");
            }
            if (f01) { float* zp = zb + ((size_t)gi * 4 + fr) * 5632 + zcol0;
#pragma unroll
                for (int bj = 0; bj < 2; ++bj) { *(f32x4*)(zp + bj * HALF) = acc[ai][bj][0][0]; *(f32x4*)(zp + bj * HALF + 4) = acc[ai][bj][0][1]; } }
            if (fr >= 14) { float* zp = zb + ((size_t)gi * 4 + (fr - 12)) * 5632 + zcol0;
#pragma unroll
                for (int bj = 0; bj < 2; ++bj) { *(f32x4*)(zp + bj * HALF) = acc[ai][bj][3][0]; *(f32x4*)(zp + bj * HALF + 4) = acc[ai][bj][3][1]; } }
        }
    }
};
struct BrOrder {
    StaticOrder base; int nM;
    __device__ void init(int M, int G_, int c_) { base.init(M, 1024, G_, c_); nM = M / BM; }
    __device__ bool next(int i, Unit& u) const { const int ti = i / 3, br = i - 3 * ti; Unit t; if (!base.next(ti, t)) return false; u.pm = br * nM + t.pm; u.pn = br * 4 + t.pn; return true; }
    __device__ __forceinline__ void a_ready(const Unit&) const {}
    __device__ __forceinline__ void done(const Unit&) const {}
};

template <class Epi, class Sched, bool ALIGN_EPI = false, bool SP2 = false>
__device__ __forceinline__ void gemm_phase(PG8_LAS unsigned char* lds, const Gemm g, const Sched& S, const Epi& E) {
    int tid_ = threadIdx.x; asm volatile("" : "+v"(tid_));
    const int tid = tid_, wid = __builtin_amdgcn_readfirstlane(tid >> 6), lane = tid & 63, wr = wid >> 2, wc = wid & 3, fr = lane & 15, fq = lane >> 4;
    const int K = g.K, nt = K / BK;
    unsigned voffA[2], voffB[2];
#pragma unroll
    for (int i = 0; i < 2; ++i) { int R, C; stage_rc(tid * 16 + i * 8192, R, C); const int Rb = Epi::PERM ? ((R & ~31) + perm32(R & 31)) : R;
        voffA[i] = (unsigned)(R * K + C) * 2u; voffB[i] = (unsigned)(Rb * K + C) * 2u; }
    const size_t kstep = (size_t)(BK * 2);
    const size_t hstep = (size_t)HALF * K * 2;
    const size_t tstep = 2 * hstep;
    const unsigned ldsw = (unsigned)wid * 1024u;
    const int aoff = lds_byte(wr * 64 + fr, fq * 8), boff = lds_byte(wc * 32 + fr, fq * 8);
#define PG8_SA(b, h) (((b) * 2 + (h)) * HTB)
#define PG8_SB(b, h) ((4 + (b) * 2 + (h)) * HTB)
#define PG8_STAGE(bufoff, gbase, voff) do { _Pragma("unroll") for (int _i = 0; _i < 2; ++_i) \
        __builtin_amdgcn_global_load_lds((const unsigned*)((const char*)(gbase) + (voff)[_i]), (PG8_LAS unsigned*)(lds + (bufoff) + ldsw + _i * 8192), 16, 0, 0); } while (0)
#define PG8_LDA(dst, b, h) do { _Pragma("unroll") for (int m = 0; m < 4; ++m) _Pragma("unroll") for (int k = 0; k < 2; ++k) dst[m][k] = *(const PG8_LAS bf16x8*)(lds + PG8_SA(b, h) + aoff + m * 2048 + k * 1024); } while (0)
#define PG8_LDB(dst, b, h) do { _Pragma("unroll") for (int n = 0; n < 2; ++n) _Pragma("unroll") for (int k = 0; k < 2; ++k) dst[n][k] = *(const PG8_LAS bf16x8*)(lds + PG8_SB(b, h) + boff + n * 2048 + k * 1024); } while (0)
#define PG8_MMA(ai, bj, At, Bt) do { __builtin_amdgcn_s_setprio(1); _Pragma("unroll") for (int m = 0; m < 4; ++m) _Pragma("unroll") for (int n = 0; n < 2; ++n) _Pragma("unroll") for (int k = 0; k < 2; ++k) \
        acc[ai][bj][m][n] = __builtin_amdgcn_mfma_f32_16x16x32_bf16(Bt[n][k], At[m][k], acc[ai][bj][m][n], 0, 0, 0); __builtin_amdgcn_s_setprio(0); } while (0)
#define PG8_WAIT_V(n) asm volatile("s_waitcnt vmcnt(" #n ")" ::: "memory")
#define PG8_WAIT_L(n) asm volatile("s_waitcnt lgkmcnt(" #n ")" ::: "memory")
#define PG8_BAR __builtin_amdgcn_s_barrier()
#define PG8_SCHED __builtin_amdgcn_sched_barrier(0)
    Unit cur, nxt; int ui = 0;
    if (!S.next(0, cur)) return;
    f32x4 acc[2][2][4][2];
#pragma unroll
    for (int a = 0; a < 2; ++a)
#pragma unroll
        for (int b = 0; b < 2; ++b)
#pragma unroll
            for (int m = 0; m < 4; ++m)
#pragma unroll
                for (int n = 0; n < 2; ++n) acc[a][b][m][n] = (f32x4){0.f, 0.f, 0.f, 0.f};
    bf16x8 At[4][2], B0[2][2], B1[2][2];
    const char* cA = (const char*)g.A + (size_t)cur.pm * tstep; const char* cB = (const char*)g.Bt + (size_t)cur.pn * tstep;
    S.a_ready(cur);
    if constexpr (SP2) {
        PG8_STAGE(PG8_SB(0, 0), cB, voffB); PG8_STAGE(PG8_SB(0, 1), cB + hstep, voffB); PG8_STAGE(PG8_SA(0, 0), cA, voffA); PG8_STAGE(PG8_SA(0, 1), cA + hstep, voffA);
        if (wr == 1) PG8_BAR;
        PG8_WAIT_V(2); PG8_BAR;
        PG8_STAGE(PG8_SB(1, 0), cB + kstep, voffB); PG8_STAGE(PG8_SA(1, 0), cA + kstep, voffA); PG8_STAGE(PG8_SB(1, 1), cB + hstep + kstep, voffB);
        PG8_WAIT_V(6); PG8_BAR;
    } else {
        PG8_STAGE(PG8_SB(0, 0), cB, voffB); PG8_STAGE(PG8_SA(0, 0), cA, voffA); PG8_STAGE(PG8_SB(0, 1), cB + hstep, voffB); PG8_STAGE(PG8_SA(0, 1), cA + hstep, voffA);
        if (wr == 1) PG8_BAR;
        PG8_WAIT_V(4); PG8_BAR;
        PG8_STAGE(PG8_SB(1, 0), cB + kstep, voffB); PG8_STAGE(PG8_SA(1, 0), cA + kstep, voffA); PG8_STAGE(PG8_SB(1, 1), cB + hstep + kstep, voffB);
        PG8_WAIT_V(6); PG8_BAR;
    }
    for (;;) {
        const bool has_next = S.next(ui + 1, nxt);
        const char* nA = has_next ? (const char*)g.A + (size_t)nxt.pm * tstep : cA; const char* nB = has_next ? (const char*)g.Bt + (size_t)nxt.pn * tstep : cB;
        for (int t = 0; t < nt; t += 2) {
            const bool last = (t == nt - 2);
            const char* a1 = cA + (size_t)(t + 1) * kstep;
            const char* a2 = last ? nA : cA + (size_t)(t + 2) * kstep; const char* b2 = last ? nB : cB + (size_t)(t + 2) * kstep;
            const char* a3 = a2 + kstep; const char* b3 = b2 + kstep;
            if (last && has_next) S.a_ready(nxt);
            if constexpr (SP2) {
            PG8_LDB(B0, 0, 0); PG8_LDB(B1, 0, 1); PG8_SCHED; PG8_LDA(At, 0, 0); PG8_STAGE(PG8_SA(1, 1), a1 + hstep, voffA);
            PG8_WAIT_V(8); PG8_WAIT_L(0); PG8_BAR; PG8_MMA(0, 0, At, B0); PG8_MMA(0, 1, At, B1); PG8_BAR; PG8_SCHED;
            PG8_LDA(At, 0, 1); PG8_STAGE(PG8_SB(0, 0), b2, voffB); PG8_STAGE(PG8_SB(0, 1), b2 + hstep, voffB); PG8_STAGE(PG8_SA(0, 0), a2, voffA);
            PG8_WAIT_V(8); PG8_WAIT_L(0); PG8_BAR; PG8_MMA(1, 0, At, B0); PG8_MMA(1, 1, At, B1); PG8_BAR; PG8_SCHED;
            PG8_LDB(B0, 1, 0); PG8_LDB(B1, 1, 1); PG8_SCHED; PG8_LDA(At, 1, 0); PG8_STAGE(PG8_SA(0, 1), a2 + hstep, voffA);
            PG8_WAIT_V(8); PG8_WAIT_L(0); PG8_BAR; PG8_MMA(0, 0, At, B0); PG8_MMA(0, 1, At, B1); PG8_BAR; PG8_SCHED;
            PG8_LDA(At, 1, 1); PG8_STAGE(PG8_SB(1, 0), b3, voffB); PG8_STAGE(PG8_SB(1, 1), b3 + hstep, voffB); PG8_STAGE(PG8_SA(1, 0), a3, voffA);
            PG8_WAIT_V(8); PG8_WAIT_L(0); PG8_BAR; PG8_MMA(1, 0, At, B0); PG8_MMA(1, 1, At, B1); PG8_BAR; PG8_SCHED;
            } else {
            PG8_LDB(B0, 0, 0); PG8_SCHED; PG8_LDA(At, 0, 0); PG8_STAGE(PG8_SA(1, 1), a1 + hstep, voffA);
            PG8_WAIT_L(8); PG8_BAR; PG8_WAIT_L(0); PG8_MMA(0, 0, At, B0); PG8_BAR; PG8_SCHED;
            PG8_LDB(B1, 0, 1); PG8_STAGE(PG8_SB(0, 0), b2, voffB);
            PG8_BAR; PG8_WAIT_L(0); PG8_MMA(0, 1, At, B1); PG8_BAR;
            PG8_LDA(At, 0, 1); PG8_STAGE(PG8_SA(0, 0), a2, voffA);
            PG8_BAR; PG8_WAIT_L(0); PG8_MMA(1, 0, At, B0); PG8_BAR; PG8_SCHED;
            PG8_STAGE(PG8_SB(0, 1), b2 + hstep, voffB);
            PG8_WAIT_V(6); PG8_BAR; PG8_MMA(1, 1, At, B1); PG8_BAR;
            PG8_LDB(B0, 1, 0); PG8_SCHED; PG8_LDA(At, 1, 0); PG8_STAGE(PG8_SA(0, 1), a2 + hstep, voffA);
            PG8_WAIT_L(8); PG8_BAR; PG8_WAIT_L(0); PG8_MMA(0, 0, At, B0); PG8_BAR; PG8_SCHED;
            PG8_LDB(B1, 1, 1); PG8_STAGE(PG8_SB(1, 0), b3, voffB);
            PG8_BAR; PG8_WAIT_L(0); PG8_MMA(0, 1, At, B1); PG8_BAR;
            PG8_LDA(At, 1, 1); PG8_STAGE(PG8_SA(1, 0), a3, voffA);
            PG8_BAR; PG8_WAIT_L(0); PG8_MMA(1, 0, At, B0); PG8_BAR; PG8_SCHED;
            PG8_STAGE(PG8_SB(1, 1), b3 + hstep, voffB);
            PG8_WAIT_V(6); PG8_BAR; PG8_MMA(1, 1, At, B1); PG8_BAR;
            }
        }
        if constexpr (ALIGN_EPI) { if (wr == 0) PG8_BAR; }
        if constexpr (!Epi::AFTER_DRAIN) { E(acc, cur, wr, wc, fr, fq); S.done(cur); }
        if (!has_next) break;
        if (E.zero_after(cur)) {
#pragma unroll
        for (int a = 0; a < 2; ++a)
#pragma unroll
            for (int b = 0; b < 2; ++b)
#pragma unroll
                for (int m = 0; m < 4; ++m)
#pragma unroll
                    for (int n = 0; n < 2; ++n) acc[a][b][m][n] = (f32x4){0.f, 0.f, 0.f, 0.f};
        }
        cur = nxt; cA = nA; cB = nB; ++ui;
        if constexpr (ALIGN_EPI) { if (wr == 1) PG8_BAR; }
    }
    PG8_WAIT_V(0);
    if constexpr (!ALIGN_EPI) { if (wr == 0) PG8_BAR; }
    PG8_BAR;
    if constexpr (Epi::AFTER_DRAIN) { E.fused(acc, cur, wr, wc, fr, fq, lds, wid, lane); S.done(cur); }
#undef PG8_SA
#undef PG8_SB
#undef PG8_STAGE
#undef PG8_LDA
#undef PG8_LDB
#undef PG8_MMA
#undef PG8_WAIT_V
#undef PG8_WAIT_L
#undef PG8_BAR
#undef PG8_SCHED
}
}


#define LAS __attribute__((address_space(3)))
typedef unsigned short bf16_t;
typedef float f32x4 __attribute__((ext_vector_type(4)));
typedef float f32x16 __attribute__((ext_vector_type(16)));
typedef unsigned u32x4 __attribute__((ext_vector_type(4)));
typedef unsigned u32x2 __attribute__((ext_vector_type(2)));
typedef short bf16x8 __attribute__((ext_vector_type(8)));
typedef short s16x4 __attribute__((ext_vector_type(4)));
using pg8::pk2; using pg8::bf_lo; using pg8::bf_hi; using pg8::pack8;

constexpr int T_ALL = 65536, SEQ = 2048, NBATCH = 32, DM = 1024, NS = 2, TS = T_ALL / NS, BPS = NBATCH / NS;
constexpr int IN_W = 6592, N1 = 6656, NQ = 1536, DFF = 2816, NUP = 5632;
constexpr size_t MiB = 1u << 20;
constexpr size_t OFF_MOD = 0, OFF_COS = 2 * MiB, OFF_SIN = 10 * MiB, OFF_WSB = 18 * MiB, OFF_WL = 20 * MiB, WL_STRIDE = 40 * MiB;
constexpr size_t WO_W1 = 0, WO_WQ = 13 * MiB, WO_WBR = 14 * MiB, WO_WO = 20 * MiB, WO_WUP = 22 * MiB, WO_WDN = 33 * MiB;
constexpr size_t OFF_H = 128 * MiB, OFF_GATES = 192 * MiB, OFF_APOOL = 384 * MiB, OFF_RAW = 448 * MiB, OFF_PART = 384 * MiB, OFF_UV = 512 * MiB, OFF_QP = 512 * MiB,
                 OFF_BR = 640 * MiB, OFF_CQN = 832 * MiB, OFF_K192 = 848 * MiB, OFF_VT = 860 * MiB, OFF_Z = 192 * MiB, OFF_FF = 544 * MiB, OFF_Y = 720 * MiB, WS_NEED = 868 * MiB;
constexpr int LDS_BYTES = 147456, LDS_BARST = 131072 + 256;
constexpr size_t OFF_BAR = 1835008, BAR_BYTES = 16384;
constexpr float LN_EPS = 1e-5f, RMS_EPS = 1e-6f;

struct Params {
    const float* x; const float* c; const int* pos; const float* w_ada; const float* b_ada; const float* w_in; const float* w_pool; const float* s_pool; const float* g_q; const float* w_uq;
    const float* g_kv; const float* w_ukv; const float* g_sg; const float* b_sg; const float* w_s; const float* b_s; const float* w_branch; const float* w_o; const float* ln_t_g; const float* ln_t_b;
    const float* w_up; const float* conv_w; const float* conv_b; const float* w_down; const float* ln_f_g; const float* ln_f_b;
    float* out; unsigned char* ws;
};

#define LOADS_DONE() do { asm volatile("" ::: "memory"); __builtin_amdgcn_sched_barrier(0); } while (0)
__device__ __forceinline__ int tid_opaque() { int t = threadIdx.x; asm volatile("" : "+v"(t)); return t; }
__device__ __forceinline__ float dpp_f(float v, const int ctrl_sel) {
    const int x = __builtin_bit_cast(int, v); int r;
    if (ctrl_sel == 0) r = __builtin_amdgcn_update_dpp(0, x, 0xB1, 0xF, 0xF, true);
    else if (ctrl_sel == 1) r = __builtin_amdgcn_update_dpp(0, x, 0x4E, 0xF, 0xF, true);
    else if (ctrl_sel == 2) r = __builtin_amdgcn_update_dpp(0, x, 0x141, 0xF, 0xF, true);
    else r = __builtin_amdgcn_update_dpp(0, x, 0x140, 0xF, 0xF, true);
    return __builtin_bit_cast(float, r);
}
__device__ __forceinline__ float wave_sum(float v) {
    v += dpp_f(v, 0); v += dpp_f(v, 1); v += dpp_f(v, 2); v += dpp_f(v, 3);
    const int x = __builtin_bit_cast(int, v);
    const float r0 = __builtin_bit_cast(float, __builtin_amdgcn_readlane(x, 0)), r1 = __builtin_bit_cast(float, __builtin_amdgcn_readlane(x, 16)),
                r2 = __builtin_bit_cast(float, __builtin_amdgcn_readlane(x, 32)), r3 = __builtin_bit_cast(float, __builtin_amdgcn_readlane(x, 48));
    return (r0 + r1) + (r2 + r3);
}

#define XB_TMO      128
#define XB_XCNT(j)  (256  + 64 * (j))
#define XB_XSUB(j)  (1280 + 64 * (j))
#define XB_XGEN(j)  (2304 + 64 * (j))
#define XB_TOP      3328
#define XB_TOPGEN   3392
#define XCD_BAR_WORDS 3456
#define XB_SPIN_CAP (1u << 18)

__device__ __forceinline__ unsigned xb_ld(unsigned* p)              { return __hip_atomic_load(p, __ATOMIC_RELAXED, __HIP_MEMORY_SCOPE_AGENT); }
__device__ __forceinline__ unsigned xb_add(unsigned* p, unsigned v) { return __hip_atomic_fetch_add(p, v, __ATOMIC_RELAXED, __HIP_MEMORY_SCOPE_AGENT); }
__device__ __forceinline__ unsigned xb_xcc_id() { return (unsigned)__builtin_amdgcn_s_getreg((3 << 11) | 20) & 0xFu; }
#define XB_SPIN(cond, bar) do { unsigned _sp = 0; while (cond) { __builtin_amdgcn_s_sleep(1); \
    if ((++_sp & 255u) == 0u) { if (xb_ld(&(bar)[XB_TMO])) break; if (_sp > XB_SPIN_CAP) { atomicAdd(&(bar)[XB_TMO], 1u); break; } } } } while (0)

struct XcdBarrier {
    unsigned* bar; unsigned x;
    volatile LAS unsigned* st;
};

__device__ __forceinline__ XcdBarrier xcd_barrier_post(unsigned* bar, volatile LAS unsigned* st) {
    XcdBarrier b; b.bar = bar; b.x = xb_xcc_id(); b.st = st;
    if (threadIdx.x == 0) (void)xb_add(&bar[XB_XCNT(b.x)], 1u);
    return b;
}
__device__ __forceinline__ void xcd_barrier_complete(unsigned* bar, unsigned x, unsigned& nloc, unsigned& nx) {
    const unsigned G = gridDim.x * gridDim.y * gridDim.z;
    unsigned sum, cnt, mine, sp = 0u;
    for (;;) {
        sum = 0u; cnt = 0u; mine = 0u;
#pragma unroll
        for (unsigned j = 0; j < 16; ++j) { const unsigned c = xb_ld(&bar[XB_XCNT(j)]); sum += c; cnt += (c > 0u) ? 1u : 0u; mine = (j == x) ? c : mine; }
        if (sum == G) break;
        __builtin_amdgcn_s_sleep(1);
        if ((++sp & 255u) == 0u) { if (xb_ld(&bar[XB_TMO])) break; if (sp > XB_SPIN_CAP) { atomicAdd(&bar[XB_TMO], 1u); break; } }
    }
    nloc = mine > 0u ? mine : 1u; nx = cnt > 0u ? cnt : 1u;
}

__device__ __forceinline__ void xcd_barrier(const XcdBarrier& b) {
    asm volatile("s_waitcnt vmcnt(0)" ::: "memory");
    __syncthreads();
    if (threadIdx.x == 0) {
        unsigned* bar = b.bar;
        __builtin_amdgcn_s_waitcnt(0);
        unsigned nloc = b.st[0], nx = b.st[1];
        if (nloc == 0u) { xcd_barrier_complete(bar, b.x, nloc, nx); b.st[0] = nloc; b.st[1] = nx; }
        const unsigned old = xb_add(&bar[XB_XSUB(b.x)], 1u);
        const unsigned gen = old / nloc;
        if (old + 1u == (gen + 1u) * nloc) {
            __builtin_amdgcn_fence(__ATOMIC_RELEASE, "agent");
            asm volatile("s_waitcnt vmcnt(0)" ::: "memory");
            const unsigned og = xb_add(&bar[XB_TOP], 1u);
            const unsigned tg = og / nx;
            if (og + 1u == (tg + 1u) * nx) xb_add(&bar[XB_TOPGEN], 1u);
            else XB_SPIN(xb_ld(&bar[XB_TOPGEN]) == tg, bar);
            __builtin_amdgcn_fence(__ATOMIC_ACQUIRE, "agent");
            xb_add(&bar[XB_XGEN(b.x)], 1u);
            asm volatile("s_waitcnt vmcnt(0)" ::: "memory");
        } else {
            XB_SPIN(xb_ld(&bar[XB_XGEN(b.x)]) == gen, bar);
            __builtin_amdgcn_fence(__ATOMIC_ACQUIRE, "agent");
            asm volatile("s_waitcnt vmcnt(0)" ::: "memory");
        }
    }
    __syncthreads();
}


__device__ __forceinline__ void xpose_tile(const float* src, int ld, int k0, int c0, bf16_t* dst, int ldd, int n0, LAS float* tile) {
    const int tid = tid_opaque(), r = tid >> 3, cc = (tid & 7) * 8;
    f32x4 a = {0.f, 0.f, 0.f, 0.f}, b = {0.f, 0.f, 0.f, 0.f};
    if (c0 >= 0) { const float* s = src + (size_t)(k0 + r) * ld + c0 + cc; a = *(const f32x4*)s; b = *(const f32x4*)(s + 4); }
#pragma unroll
    for (int e = 0; e < 4; ++e) { tile[r * 65 + cc + e] = a[e]; tile[r * 65 + cc + 4 + e] = b[e]; }
    __syncthreads();
    float v[8];
#pragma unroll
    for (int e = 0; e < 8; ++e) v[e] = tile[(cc + e) * 65 + r];
    u32x4 w; w.x = pk2(v[0], v[1]); w.y = pk2(v[2], v[3]); w.z = pk2(v[4], v[5]); w.w = pk2(v[6], v[7]);
    *(u32x4*)(dst + (size_t)(n0 + r) * ldd + k0 + cc) = w;
    __syncthreads();
}

typedef const Params __attribute__((address_space(4)))* KPtr;
__device__ __forceinline__ KPtr kparams() { KPtr k = (KPtr)__builtin_amdgcn_kernarg_segment_ptr(); asm volatile("" : "+s"(k)); return k; }
__device__ __forceinline__ void prep_phase(KPtr pp, LAS unsigned char* lds, int G, int bid) {
    const int tid = tid_opaque(), lane = tid & 63, wid = tid >> 6;
    const int gtid = bid * 512 + tid, gsz = G * 512;
    unsigned char* ws = pp->ws;
    { float* COS = (float*)(ws + OFF_COS); float* SIN = (float*)(ws + OFF_SIN);
      for (int i = gtid; i < T_ALL * 32; i += gsz) {
          const int t = i >> 5, f = i & 31;
          double fr = 1.0; for (int k = 0; k < f; ++k) fr *= 0.7498942093324559;
          const double ang = (double)pp->pos[t] * fr;
          const double kq = __builtin_rint(ang * 0.15915494309189535);
          double r = __builtin_fma(-kq, 6.283185307179586, ang); r = __builtin_fma(-kq, 2.4492935982947064e-16, r);
          const double r2 = r * r; double sn = 1.0, cs = 1.0;
          _Pragma("unroll") for (int k = 15; k >= 1; --k) { sn = 1.0 - sn * r2 * (1.0 / (double)((2 * k) * (2 * k + 1))); cs = 1.0 - cs * r2 * (1.0 / (double)((2 * k - 1) * (2 * k))); }
          COS[i] = (float)cs; SIN[i] = (float)(sn * r);
      } }
    { bf16_t* WSB = (bf16_t*)(ws + OFF_WSB);
      for (int i = gtid; i < 2 * 8 * 128 * 128 / 2; i += gsz) { const int e = i * 2, tt = (e >> 7) & 127, ss = e & 127;
          const float a = ss <= tt ? pp->w_s[e] : 0.f, b = (ss + 1) <= tt ? pp->w_s[e + 1] : 0.f; ((unsigned*)WSB)[i] = pk2(a, b); } }
    { LAS float* tile = (LAS float*)lds;
      const int r = tid >> 3, cc = (tid & 7) * 8;
      for (int tb4 = bid * 4; tb4 < 2 * 4288; tb4 += G * 4) {
          f32x4 va[4], vb[4]; bf16_t* dptr[4];
#pragma unroll
          for (int q = 0; q < 4; ++q) {
              const int ti = tb4 + q; const int l = ti / 4288; int rr = ti - l * 4288; unsigned char* wl = ws + OFF_WL + (size_t)l * WL_STRIDE;
              const float* src; int ld, k0, c0, ldd, n0; bf16_t* dst;
              if (rr < 1664) { const int nb = rr >> 4, kb = rr & 15; n0 = nb * 64; k0 = kb * 64;
                  if (n0 < 4096) c0 = n0; else if (n0 < 6144) c0 = 4544 + (n0 - 4096); else if (n0 < 6400) c0 = 4096 + (n0 - 6144); else if (n0 < 6528) c0 = 4352 + (n0 - 6400); else if (n0 < 6592) c0 = 4480 + (n0 - 6528); else c0 = -1;
                  src = pp->w_in + (size_t)l * 1024 * IN_W; ld = IN_W; dst = (bf16_t*)(wl + WO_W1); ldd = 1024; }
              else if (rr < 1920) { rr -= 1664; const int nb = rr >> 4, kb = rr & 15; n0 = nb * 64; k0 = kb * 64; c0 = n0; src = pp->w_branch + ((size_t)l * 3 + 2) * 1048576; ld = 1024; dst = (bf16_t*)(wl + WO_WBR) + 2 * 1048576; ldd = 1024; }
              else if (rr < 2176) { rr -= 1920; const int nb = rr >> 4, kb = rr & 15; n0 = nb * 64; k0 = kb * 64; c0 = n0; src = pp->w_o + (size_t)l * 1048576; ld = 1024; dst = (bf16_t*)(wl + WO_WO); ldd = 1024; }
              else if (rr < 3584) { rr -= 2176; const int nb = rr >> 4, kb = rr & 15; n0 = nb * 64; k0 = kb * 64; const int uu = n0 >> 8, cc0 = n0 & 255; c0 = (cc0 >> 7) * DFF + 128 * uu + (cc0 & 127);
                  src = pp->w_up + (size_t)l * 1024 * NUP; ld = NUP; dst = (bf16_t*)(wl + WO_WUP); ldd = 1024; }
              else { rr -= 3584; const int nb = rr / 44, kb = rr - nb * 44; n0 = nb * 64; k0 = kb * 64; c0 = n0; src = pp->w_down + (size_t)l * DFF * 1024; ld = 1024; dst = (bf16_t*)(wl + WO_WDN); ldd = DFF; }
              if (c0 >= 0) { const float* s = src + (size_t)(k0 + r) * ld + c0 + cc; va[q] = *(const f32x4*)s; vb[q] = *(const f32x4*)(s + 4); }
              else { va[q] = (f32x4){0.f, 0.f, 0.f, 0.f}; vb[q] = (f32x4){0.f, 0.f, 0.f, 0.f}; }
              dptr[q] = dst + (size_t)(n0 + r) * ldd + k0 + cc;
          }
#pragma unroll
          for (int q = 0; q < 4; ++q)
#pragma unroll
              for (int e = 0; e < 4; ++e) { tile[q * 4160 + r * 65 + cc + e] = va[q][e]; tile[q * 4160 + r * 65 + cc + 4 + e] = vb[q][e]; }
          __syncthreads();
#pragma unroll
          for (int q = 0; q < 4; ++q) { float v[8];
#pragma unroll
              for (int e = 0; e < 8; ++e) v[e] = tile[q * 4160 + (cc + e) * 65 + r];
              u32x4 w; w.x = pk2(v[0], v[1]); w.y = pk2(v[2], v[3]); w.z = pk2(v[4], v[5]); w.w = pk2(v[6], v[7]);
              *(u32x4*)dptr[q] = w; }
          __syncthreads();
      } }
    for (int item = bid * 8 + wid; item < 1024; item += G * 8) { const int l = item >> 9, h = (item >> 6) & 7, jb = (item >> 2) & 15, r = (item & 3) * 64 + lane;
        const float* a = pp->w_uq + ((size_t)(l * 256 + r) * 8 + h) * 192; const float* b = pp->w_ukv + ((size_t)(l * 128 + jb * 8) * 8 + h) * 256; float acc[8];
#pragma unroll
        for (int i = 0; i < 8; ++i) acc[i] = 0.f;
#pragma unroll 4
        for (int d = 0; d < 128; d += 4) { const f32x4 av = *(const f32x4*)(a + d);
#pragma unroll
            for (int i = 0; i < 8; ++i) { const f32x4 bv = *(const f32x4*)(b + (size_t)i * 2048 + d); acc[i] += (av[0] * bv[0] + av[1] * bv[1]) + (av[2] * bv[2] + av[3] * bv[3]); } }
        bf16_t* dq = (bf16_t*)(ws + OFF_WL + (size_t)l * WL_STRIDE + WO_WQ) + (size_t)(h * 128 + jb * 8) * 256 + r;
#pragma unroll
        for (int i = 0; i < 8; ++i) dq[(size_t)i * 256] = (bf16_t)(pk2(acc[i], 0.f) & 0xffffu); }
    for (int i = gtid; i < 2 * 512 * 256; i += gsz) { const int l = i >> 17, n = (i >> 8) & 511, r = i & 255, u2 = n >> 8, cc = n & 255, bj = cc >> 7, h = 4 * u2 + ((cc >> 5) & 3), dd = 128 + (cc & 31) + 32 * bj;
        const float v = pp->w_uq[((size_t)(l * 256 + r) * 8 + h) * 192 + dd];
        ((bf16_t*)(ws + OFF_WL + (size_t)l * WL_STRIDE + WO_WQ))[(size_t)(1024 + n) * 256 + r] = (bf16_t)(pk2(v, 0.f) & 0xffffu); }
    for (int item = bid * 8 + wid; item < 8192; item += G * 8) { const int l = item >> 12, which = (item >> 11) & 1, kk = ((item >> 7) & 15) * 64 + lane, n0 = (item & 127) * 8;
        const float* a; const float* b; const float* sp = nullptr; int K;
        if (which == 1) { const int h = kk >> 7, j = kk & 127; a = pp->w_ukv + ((size_t)(l * 128 + j) * 8 + h) * 256 + 128; b = pp->w_branch + ((size_t)(l * 3 + 1) * 1024 + (size_t)__builtin_amdgcn_readfirstlane(h) * 128) * 1024 + n0; K = 128; }
        else { const int g = __builtin_amdgcn_readfirstlane(kk >> 8), c = kk & 255; a = pp->w_pool + ((size_t)(l * 4 + g) * 256 + c) * 256; sp = pp->s_pool + l * 1024 + g * 256; b = pp->w_branch + ((size_t)(l * 3 + 0) * 1024 + g * 256) * 1024 + n0; K = 256; }
        float acc[8];
#pragma unroll
        for (int i = 0; i < 8; ++i) acc[i] = 0.f;
#pragma unroll 2
        for (int d = 0; d < K; d += 4) { f32x4 av = *(const f32x4*)(a + d); if (sp) av *= *(const f32x4*)(sp + d);
#pragma unroll
            for (int dd = 0; dd < 4; ++dd) { const f32x4 b0 = *(const f32x4*)(b + (size_t)(d + dd) * 1024), b1 = *(const f32x4*)(b + (size_t)(d + dd) * 1024 + 4);
                acc[0] += av[dd] * b0[0]; acc[1] += av[dd] * b0[1]; acc[2] += av[dd] * b0[2]; acc[3] += av[dd] * b0[3]; acc[4] += av[dd] * b1[0]; acc[5] += av[dd] * b1[1]; acc[6] += av[dd] * b1[2]; acc[7] += av[dd] * b1[3]; } }
        bf16_t* dw = (bf16_t*)(ws + OFF_WL + (size_t)l * WL_STRIDE + WO_WBR) + ((size_t)which * 1024 + n0) * 1024 + kk;
#pragma unroll
        for (int i = 0; i < 8; ++i) dw[(size_t)i * 1024] = (bf16_t)(pk2(acc[i], 0.f) & 0xffffu); }
    { LAS float* tab = (LAS float*)lds; LAS float* part = tab + 16384; float* MOD = (float*)(ws + OFF_MOD);
      __syncthreads();
      for (int it = bid; it < 384; it += G) { const int l = it / 192, rem = it - l * 192, nc = rem >> 1, bh = rem & 1;
          for (int i = tid; i < 16384; i += 512) { const int k = i >> 4, bb = i & 15; const float cv = pp->c[(bh * 16 + bb) * 1024 + k]; tab[i] = cv / (1.0f + __expf(-cv)); }
          __syncthreads();
          float acc[16];
#pragma unroll
          for (int b = 0; b < 16; ++b) acc[b] = 0.f;
          const float* wp = pp->w_ada + ((size_t)l * 1024 + wid * 128) * 6144 + nc * 64 + lane;
          _Pragma("unroll 8") for (int k = 0; k < 128; ++k) { const float wv = wp[(size_t)k * 6144]; const LAS f32x4* tp = (const LAS f32x4*)(tab + (wid * 128 + k) * 16);
#pragma unroll
              for (int q = 0; q < 4; ++q) { const f32x4 tv = tp[q]; acc[4 * q] += tv[0] * wv; acc[4 * q + 1] += tv[1] * wv; acc[4 * q + 2] += tv[2] * wv; acc[4 * q + 3] += tv[3] * wv; } }
#pragma unroll
          for (int b = 0; b < 16; ++b) part[(wid * 16 + b) * 64 + lane] = acc[b];
          __syncthreads();
          for (int o = tid; o < 1024; o += 512) { const int bb = o >> 6, nn = o & 63; float s = pp->b_ada[l * 6144 + nc * 64 + nn];
#pragma unroll
              for (int w = 0; w < 8; ++w) s += part[(w * 16 + bb) * 64 + nn];
              MOD[(size_t)(l * 32 + bh * 16 + bb) * 6144 + nc * 64 + nn] = s; }
          __syncthreads();
      } }
}

__device__ __forceinline__ void row_stats(const f32x4 (&v)[4], float& mean, float& rstd) {
    float s = 0.f;
#pragma unroll
    for (int q = 0; q < 4; ++q) s += (v[q][0] + v[q][1]) + (v[q][2] + v[q][3]);
    mean = wave_sum(s) * (1.0f / 1024.0f); float qq = 0.f;
#pragma unroll
    for (int q = 0; q < 4; ++q) { const f32x4 d = v[q] - mean; qq += (d[0] * d[0] + d[1] * d[1]) + (d[2] * d[2] + d[3] * d[3]); }
    rstd = 1.0f / sqrtf(wave_sum(qq) * (1.0f / 1024.0f) + LN_EPS);
}
template <int MODE, bool HOUT>
__device__ __forceinline__ void ln_pass(const float* xin, const bf16_t* yin, const float* gate, float* xout, bf16_t* hout, int tok0, const float* lng, const float* lnb, const float* modsh, const float* modsc, int G, int bid) {
    const int tid = tid_opaque(), lane = tid & 63, wid = tid >> 6;
    const float ALPHA = 1.4142135623730951f;
    constexpr int NR = 4, RPB = SEQ;
    const int nwaves = G * 8, wpb = nwaves / BPS;
    const int gw = bid * 8 + wid, bl = gw / wpb, wi = gw - bl * wpb;
    if (bl >= BPS) return;
    const int b = (tok0 >> 11) + bl;
    f32x4 gv[4], lg[4], lb[4], sc[4], sh[4];
#pragma unroll
    for (int q = 0; q < 4; ++q) {
        if (MODE == 1) { gv[q] = *(const f32x4*)(gate + (size_t)b * 6144 + lane * 4 + q * 256); lg[q] = *(const f32x4*)(lng + lane * 4 + q * 256); lb[q] = *(const f32x4*)(lnb + lane * 4 + q * 256); }
        if (HOUT) { sc[q] = *(const f32x4*)(modsc + (size_t)b * 6144 + lane * 4 + q * 256) + 1.0f; sh[q] = *(const f32x4*)(modsh + (size_t)b * 6144 + lane * 4 + q * 256); } }
    for (int k0 = wi; k0 < RPB; k0 += NR * wpb) {
        f32x4 v[NR][4]; u32x2 yv[NR][4];
#pragma unroll
        for (int u = 0; u < NR; ++u) { const int rl = bl * RPB + k0 + u * wpb;
            const float* xp = xin + ((size_t)tok0 + rl) * 1024 + lane * 4;
#pragma unroll
            for (int q = 0; q < 4; ++q) v[u][q] = *(const f32x4*)(xp + q * 256);
            if (MODE == 1) { const bf16_t* yp = yin + (size_t)rl * 1024 + lane * 4;
#pragma unroll
                for (int q = 0; q < 4; ++q) yv[u][q] = *(const u32x2*)(yp + q * 256); } }
        LOADS_DONE();
#pragma unroll
        for (int u = 0; u < NR; ++u) { const int rl = bl * RPB + k0 + u * wpb;
            if (MODE == 1) {
#pragma unroll
                for (int q = 0; q < 4; ++q) v[u][q] = v[u][q] * ALPHA + gv[q] * (f32x4){bf_lo(yv[u][q].x), bf_hi(yv[u][q].x), bf_lo(yv[u][q].y), bf_hi(yv[u][q].y)}; }
            float mean, rstd; row_stats(v[u], mean, rstd);
            if (MODE == 1) {
                float* op = xout + ((size_t)tok0 + rl) * 1024 + lane * 4;
#pragma unroll
                for (int q = 0; q < 4; ++q) { v[u][q] = (v[u][q] - mean) * rstd * lg[q] + lb[q]; *(f32x4*)(op + q * 256) = v[u][q]; }
                if (HOUT) row_stats(v[u], mean, rstd);
            }
            if (HOUT) {
                bf16_t* hp = hout + (size_t)rl * 1024 + lane * 4;
#pragma unroll
                for (int q = 0; q < 4; ++q) { const f32x4 y = (v[u][q] - mean) * rstd * sc[q] + sh[q]; u32x2 w; w.x = pk2(y[0], y[1]); w.y = pk2(y[2], y[3]); *(u32x2*)(hp + q * 256) = w; }
            }
        }
    }
}

__device__ __forceinline__ void unpack8(const u32x4 w, float (&f)[8]) { f[0] = bf_lo(w.x); f[1] = bf_hi(w.x); f[2] = bf_lo(w.y); f[3] = bf_hi(w.y); f[4] = bf_lo(w.z); f[5] = bf_hi(w.z); f[6] = bf_lo(w.w); f[7] = bf_hi(w.w); }

template <int W>
__device__ __forceinline__ void pool_task(const bf16_t* __restrict__ apool, bf16_t* __restrict__ pooled, int tok0, int ch) {
    constexpr int R = 8, NR = R + W - 1;
    const int s0 = tok0 & (SEQ - 1);
    u32x4 rows[NR];
#pragma unroll
    for (int i = 0; i < NR; ++i) { const int d = i - (W - 1); rows[i] = (s0 + d >= 0) ? *(const u32x4*)(apool + ((size_t)tok0 + d) * 1024 + ch * 8) : (u32x4){0u, 0u, 0u, 0u}; }
    LOADS_DONE();
    float sum[8];
#pragma unroll
    for (int e = 0; e < 8; ++e) sum[e] = 0.f;
#pragma unroll
    for (int i = 0; i < W - 1; ++i) { float t[8]; unpack8(rows[i], t);
#pragma unroll
        for (int e = 0; e < 8; ++e) sum[e] += t[e]; }
#pragma unroll
    for (int r = 0; r < R; ++r) { float cur[8], o[8]; unpack8(rows[r + W - 1], cur);
#pragma unroll
        for (int e = 0; e < 8; ++e) sum[e] += cur[e];
        if (r > 0) { float old[8]; unpack8(rows[r - 1], old);
#pragma unroll
            for (int e = 0; e < 8; ++e) sum[e] -= old[e]; }
        const int cnt = (s0 + r + 1) < W ? (s0 + r + 1) : W; const float inv = 1.0f / (float)cnt;
#pragma unroll
        for (int e = 0; e < 8; ++e) o[e] = sum[e] * inv - cur[e];
        u32x4 wv; wv.x = pk2(o[0], o[1]); wv.y = pk2(o[2], o[3]); wv.z = pk2(o[4], o[5]); wv.w = pk2(o[6], o[7]);
        *(u32x4*)(pooled + ((size_t)tok0 + r) * 1024 + ch * 8) = wv; }
}
__device__ __forceinline__ void pool_pass(const bf16_t* apool, bf16_t* pooled, int G, int bid) {
    const int gtid = bid * 512 + tid_opaque(), gsz = G * 512;
    for (int id = gtid; id < (TS / 8) * 128; id += gsz) {
        const int g = (id >> 6) & 3, ch = g * 32 + (id & 31), run = (id >> 8) * 2 + ((id >> 5) & 1), tok0 = run * 8;
        if (g == 0) pool_task<2>(apool, pooled, tok0, ch); else if (g == 1) pool_task<4>(apool, pooled, tok0, ch); else if (g == 2) pool_task<8>(apool, pooled, tok0, ch); else pool_task<16>(apool, pooled, tok0, ch);
    }
}

__device__ __forceinline__ void norm_pass(const float* raw, bf16_t* cqn, bf16_t* k192, bf16_t* vt, const float* gq, const float* gkv, const float* cosT, const float* sinT, int tok0, LAS unsigned char* lds, int G, int bid) {
    const int tid = tid_opaque(), lane = tid & 63, wid = tid >> 6;
    LAS bf16_t* tl = (LAS bf16_t*)lds;
    const f32x4 gqv = *(const f32x4*)(gq + lane * 4); const float gk0 = gkv[2 * lane], gk1 = gkv[2 * lane + 1];
    for (int it = bid; it < TS / 64; it += G) {
        f32x4 qv[8]; float k0v[8], k1v[8], x1v[8], x2v[8], csv[8], snv[8];
#pragma unroll
        for (int jj = 0; jj < 8; ++jj) { const int tok = it * 64 + wid * 8 + jj; const float* rp = raw + (size_t)tok * 512;
            qv[jj] = *(const f32x4*)(rp + lane * 4); k0v[jj] = rp[256 + 2 * lane]; k1v[jj] = rp[256 + 2 * lane + 1];
            x1v[jj] = rp[384 + (lane & 31)]; x2v[jj] = rp[416 + (lane & 31)]; const size_t tr = (size_t)(tok0 + tok) * 32 + (lane & 31); csv[jj] = cosT[tr]; snv[jj] = sinT[tr]; }
        LOADS_DONE();
#pragma unroll
        for (int jj = 0; jj < 8; ++jj) { const int j = wid * 8 + jj, tok = it * 64 + j; const f32x4 q = qv[jj]; const float k0 = k0v[jj], k1 = k1v[jj];
            const float rq = 1.0f / sqrtf(wave_sum((q[0] * q[0] + q[1] * q[1]) + (q[2] * q[2] + q[3] * q[3])) * (1.0f / 256.0f) + RMS_EPS);
            const float rk = 1.0f / sqrtf(wave_sum(k0 * k0 + k1 * k1) * (1.0f / 128.0f) + RMS_EPS);
            u32x2 w; w.x = pk2(q[0] * rq * gqv[0], q[1] * rq * gqv[1]); w.y = pk2(q[2] * rq * gqv[2], q[3] * rq * gqv[3]); *(u32x2*)(cqn + (size_t)tok * 256 + lane * 4) = w;
            const unsigned kw = pk2(k0 * rk * gk0, k1 * rk * gk1);
            *(unsigned*)(k192 + (size_t)tok * 192 + 2 * lane) = kw; *(LAS unsigned*)(tl + j * 130 + 2 * lane) = kw;
            if (lane < 32) { const float x1 = x1v[jj], x2 = x2v[jj], cs = csv[jj], sn = snv[jj];
                k192[(size_t)tok * 192 + 128 + lane] = (bf16_t)(pk2(x1 * cs - x2 * sn, 0.f) & 0xffffu); k192[(size_t)tok * 192 + 160 + lane] = (bf16_t)(pk2(x2 * cs + x1 * sn, 0.f) & 0xffffu); } }
        __syncthreads();
        { const int d = tid >> 2, part = tid & 3, tokb = it * 64, b = tokb >> 11, s0 = (tokb & (SEQ - 1)) + part * 16; unsigned w[8];
#pragma unroll
          for (int e = 0; e < 8; ++e) { const unsigned lo = tl[(part * 16 + 2 * e) * 130 + d], hi = tl[(part * 16 + 2 * e + 1) * 130 + d]; w[e] = lo | (hi << 16); }
          bf16_t* vp = vt + ((size_t)b * 128 + d) * SEQ + s0;
          *(u32x4*)vp = (u32x4){w[0], w[1], w[2], w[3]}; *(u32x4*)(vp + 8) = (u32x4){w[4], w[5], w[6], w[7]}; }
        __syncthreads();
    }
}

__device__ __forceinline__ void sgu_pass(const bf16_t* uv, bf16_t* outp, const bf16_t* wsb, const float* bs, const float* gsg, const float* bsg, LAS unsigned char* lds, int G, int bid) {
    const int tid = tid_opaque(), lane = tid & 63, wid = tid >> 6, n = lane & 31, hh = lane >> 5;
    LAS unsigned char* vnt = lds;
    LAS float* stats = (LAS float*)(lds + 128 * 272);
    const int ch = tid & 15, half = (tid >> 4) & 1, sb = tid >> 5, s0 = sb * 8 + half * 4;
    const int tb = wid & 3, cb0 = (wid >> 2) * 2, t = tb * 32 + n, nks = 2 * (tb + 1);
    for (int it = bid; it < TS / 128; it += G) {
        const int tokb = it * 128;
#pragma unroll
        for (int hb = 0; hb < 2; ++hb) { u32x4 ra[8], rb[8];
#pragma unroll
            for (int jj = 0; jj < 8; ++jj) { const bf16_t* vp = uv + (size_t)(tokb + wid * 16 + hb * 8 + jj) * 2048 + 1024 + lane * 8; ra[jj] = *(const u32x4*)vp; rb[jj] = *(const u32x4*)(vp + 512); }
            LOADS_DONE();
#pragma unroll
            for (int jj = 0; jj < 8; ++jj) { const int j = wid * 16 + hb * 8 + jj; float a[8], b[8]; unpack8(ra[jj], a); unpack8(rb[jj], b); float s = 0.f;
#pragma unroll
                for (int e = 0; e < 8; ++e) s += a[e] + b[e];
                const float mean = wave_sum(s) * (1.0f / 1024.0f); float qq = 0.f;
#pragma unroll
                for (int e = 0; e < 8; ++e) { const float da = a[e] - mean, db = b[e] - mean; qq += da * da + db * db; }
                const float rstd = 1.0f / sqrtf(wave_sum(qq) * (1.0f / 1024.0f) + LN_EPS);
                if (lane == 0) { stats[2 * j] = mean; stats[2 * j + 1] = rstd; } } }
        u32x4 xr[4];
#pragma unroll
        for (int q = 0; q < 4; ++q) xr[q] = *(const u32x4*)(uv + (size_t)(tokb + s0 + q) * 2048 + 1024 + ch * 8);
        __syncthreads();
        for (int g = 0; g < 8; ++g) {
            { float x[4][8];
#pragma unroll
              for (int q = 0; q < 4; ++q) { unpack8(xr[q], x[q]); const float mu = stats[2 * (s0 + q)], rs = stats[2 * (s0 + q) + 1];
#pragma unroll
                  for (int e = 0; e < 8; ++e) x[q][e] = (x[q][e] - mu) * rs; }
              const f32x4 g0 = *(const f32x4*)(gsg + g * 128 + ch * 8), g1 = *(const f32x4*)(gsg + g * 128 + ch * 8 + 4), b0 = *(const f32x4*)(bsg + g * 128 + ch * 8), b1 = *(const f32x4*)(bsg + g * 128 + ch * 8 + 4);
#pragma unroll
              for (int e = 0; e < 8; ++e) { const float ge = e < 4 ? g0[e & 3] : g1[e & 3], be = e < 4 ? b0[e & 3] : b1[e & 3]; u32x2 w; w.x = pk2(x[0][e] * ge + be, x[1][e] * ge + be); w.y = pk2(x[2][e] * ge + be, x[3][e] * ge + be);
                  *(LAS u32x2*)(vnt + (ch * 8 + e) * 272 + ((sb ^ ch) * 16) + half * 8) = w; } }
            __syncthreads();
            if (g < 7) {
#pragma unroll
                for (int q = 0; q < 4; ++q) xr[q] = *(const u32x4*)(uv + (size_t)(tokb + s0 + q) * 2048 + 1024 + (g + 1) * 128 + ch * 8); }
            { f32x16 acc0, acc1;
#pragma unroll
              for (int i = 0; i < 16; ++i) { acc0[i] = 0.f; acc1[i] = 0.f; }
              const size_t tok = (size_t)(tokb + t); u32x2 uw[2][4];
#pragma unroll
              for (int cbi = 0; cbi < 2; ++cbi)
#pragma unroll
                  for (int gq = 0; gq < 4; ++gq) uw[cbi][gq] = *(const u32x2*)(uv + tok * 2048 + g * 128 + (cb0 + cbi) * 32 + 8 * gq + 4 * hh);
              const float bsv = bs[t * 8 + g];
              const bf16_t* wp = wsb + ((size_t)g * 128 + t) * 128 + 8 * hh; const int c0 = cb0 * 32 + n, c1 = c0 + 32;
              bf16x8 bfr[8];
#pragma unroll
              for (int ks = 0; ks < 8; ++ks) bfr[ks] = (ks < nks) ? *(const bf16x8*)(wp + 16 * ks) : (bf16x8){0, 0, 0, 0, 0, 0, 0, 0};
              LOADS_DONE();
#pragma unroll
              for (int ks = 0; ks < 8; ++ks) if (ks < nks) {
                  const bf16x8 a0 = *(const LAS bf16x8*)(vnt + c0 * 272 + (((2 * ks + hh) ^ (c0 >> 3)) * 16)), a1 = *(const LAS bf16x8*)(vnt + c1 * 272 + (((2 * ks + hh) ^ (c1 >> 3)) * 16));
                  acc0 = __builtin_amdgcn_mfma_f32_32x32x16_bf16(a0, bfr[ks], acc0, 0, 0, 0); acc1 = __builtin_amdgcn_mfma_f32_32x32x16_bf16(a1, bfr[ks], acc1, 0, 0, 0); }
#pragma unroll
              for (int cbi = 0; cbi < 2; ++cbi)
#pragma unroll
                  for (int gq = 0; gq < 4; ++gq) { const int cc = g * 128 + (cb0 + cbi) * 32 + 8 * gq + 4 * hh; const u32x2 u2 = uw[cbi][gq];
                      const float z0 = (cbi ? acc1[4 * gq] : acc0[4 * gq]) + bsv, z1 = (cbi ? acc1[4 * gq + 1] : acc0[4 * gq + 1]) + bsv, z2 = (cbi ? acc1[4 * gq + 2] : acc0[4 * gq + 2]) + bsv, z3 = (cbi ? acc1[4 * gq + 3] : acc0[4 * gq + 3]) + bsv;
                      u32x2 w; w.x = pk2(bf_lo(u2.x) * z0, bf_hi(u2.x) * z1); w.y = pk2(bf_lo(u2.y) * z2, bf_hi(u2.y) * z3); *(u32x2*)(outp + tok * 1024 + cc) = w; } }
            __syncthreads();
        }
    }
}

constexpr int AT_KSTR = 400, AT_VSTR = 136, AT_KBYTES = 64 * AT_KSTR, AT_VBYTES = 128 * AT_VSTR, AT_STAGE = AT_KBYTES + AT_VBYTES;
__device__ __forceinline__ void attn_phase(LAS unsigned char* lds, const bf16_t* QP, const bf16_t* K192, const bf16_t* VT, bf16_t* CTX, int G, int bid) {
    const int tid = tid_opaque(), lane = tid & 63, wid = __builtin_amdgcn_readfirstlane(tid >> 6), n = lane & 31, hh = lane >> 5;
    constexpr int NITEMS = BPS * 32 * 2;
    for (int rnd = 0; rnd * G < NITEMS; ++rnd) {
        const int j = rnd * G + ((rnd & 1) ? (G - 1 - bid) : bid);
        if (j >= NITEMS) continue;
        const int c = 31 - (j >> 5), sub = j & 31, b = sub >> 1, hq = sub & 1;
        const int h = hq * 4 + (wid & 3), qs = wid >> 2;
        const size_t tq = (size_t)b * SEQ + c * 64 + qs * 32 + n;
        bf16x8 qf[12];
        { const bf16_t* qptr = QP + tq * NQ + h * 192 + 8 * hh;
#pragma unroll
          for (int ks = 0; ks < 12; ++ks) qf[ks] = *(const bf16x8*)(qptr + 16 * ks); }
        f32x16 o[4];
#pragma unroll
        for (int db = 0; db < 4; ++db)
#pragma unroll
            for (int i = 0; i < 16; ++i) o[db][i] = 0.f;
        float m_run = -__builtin_inff(), l_run = 0.f;
        const bf16_t* kbase = K192 + (size_t)b * SEQ * 192; const bf16_t* vbase = VT + (size_t)b * 128 * SEQ;
        u32x4 kr[3], vr[2];
#define AT_LOAD(kt) do { _Pragma("unroll") for (int i = 0; i < 3; ++i) { const int id = tid + 512 * i, row = id / 24, cc = id - row * 24; kr[i] = *(const u32x4*)(kbase + (size_t)((kt) * 64 + row) * 192 + cc * 8); } \
        _Pragma("unroll") for (int i = 0; i < 2; ++i) { const int id = tid + 512 * i, d = id >> 3, cc = id & 7; vr[i] = *(const u32x4*)(vbase + (size_t)d * SEQ + (kt) * 64 + cc * 8); } } while (0)
#define AT_STORE(buf) do { LAS unsigned char* sb_ = lds + (buf) * AT_STAGE; _Pragma("unroll") for (int i = 0; i < 3; ++i) { const int id = tid + 512 * i, row = id / 24, cc = id - row * 24; *(LAS u32x4*)(sb_ + row * AT_KSTR + cc * 16) = kr[i]; } \
        _Pragma("unroll") for (int i = 0; i < 2; ++i) { const int id = tid + 512 * i, d = id >> 3, cc = id & 7; LAS unsigned char* vp_ = sb_ + AT_KBYTES + d * AT_VSTR + cc * 16; *(LAS u32x2*)vp_ = (u32x2){vr[i].x, vr[i].y}; *(LAS u32x2*)(vp_ + 8) = (u32x2){vr[i].z, vr[i].w}; } } while (0)
        AT_LOAD(0); AT_STORE(0);
        __syncthreads();
        for (int kt = 0; kt <= c; ++kt) {
            if (kt < c) AT_LOAD(kt + 1);
            LOADS_DONE();
            const LAS unsigned char* Ks = lds + (kt & 1) * AT_STAGE; const LAS unsigned char* Vs = Ks + AT_KBYTES;
            f32x16 s0, s1;
#pragma unroll
            for (int i = 0; i < 16; ++i) { s0[i] = 0.f; s1[i] = 0.f; }
            { const LAS unsigned char* ka = Ks + n * AT_KSTR + hh * 16;
#pragma unroll
              for (int ks = 0; ks < 12; ++ks) { const bf16x8 a0 = *(const LAS bf16x8*)(ka + ks * 32), a1 = *(const LAS bf16x8*)(ka + 32 * AT_KSTR + ks * 32);
                  s0 = __builtin_amdgcn_mfma_f32_32x32x16_bf16(a0, qf[ks], s0, 0, 0, 0); s1 = __builtin_amdgcn_mfma_f32_32x32x16_bf16(a1, qf[ks], s1, 0, 0, 0); } }
            float mx = s0[0];
#pragma unroll
            for (int i = 1; i < 16; ++i) mx = fmaxf(mx, s0[i]);
#pragma unroll
            for (int i = 0; i < 16; ++i) mx = fmaxf(mx, s1[i]);
            mx = fmaxf(mx, __shfl_xor(mx, 32));
            const float m_new = fmaxf(m_run, mx), alpha = __builtin_amdgcn_exp2f(m_run - m_new); m_run = m_new;
            float rs = 0.f;
#pragma unroll
            for (int i = 0; i < 16; ++i) { s0[i] = __builtin_amdgcn_exp2f(s0[i] - m_new); s1[i] = __builtin_amdgcn_exp2f(s1[i] - m_new); rs += s0[i] + s1[i]; }
            rs += __shfl_xor(rs, 32); l_run = l_run * alpha + rs;
#pragma unroll
            for (int db = 0; db < 4; ++db) o[db] *= alpha;
#pragma unroll
            for (int mb = 0; mb < 2; ++mb)
#pragma unroll
                for (int jj = 0; jj < 2; ++jj) {
                    u32x4 pw;
                    if (mb == 0) { pw.x = pk2(s0[8 * jj], s0[8 * jj + 1]); pw.y = pk2(s0[8 * jj + 2], s0[8 * jj + 3]); pw.z = pk2(s0[8 * jj + 4], s0[8 * jj + 5]); pw.w = pk2(s0[8 * jj + 6], s0[8 * jj + 7]); }
                    else { pw.x = pk2(s1[8 * jj], s1[8 * jj + 1]); pw.y = pk2(s1[8 * jj + 2], s1[8 * jj + 3]); pw.z = pk2(s1[8 * jj + 4], s1[8 * jj + 5]); pw.w = pk2(s1[8 * jj + 6], s1[8 * jj + 7]); }
                    const bf16x8 pf = __builtin_bit_cast(bf16x8, pw);
                    const LAS unsigned char* va = Vs + n * AT_VSTR + (mb * 32 + 16 * jj + 4 * hh) * 2;
#pragma unroll
                    for (int db = 0; db < 4; ++db) { const s16x4 lo = *(const LAS s16x4*)(va + db * 32 * AT_VSTR), hi = *(const LAS s16x4*)(va + db * 32 * AT_VSTR + 16);
                        const bf16x8 vf = __builtin_shufflevector(lo, hi, 0, 1, 2, 3, 4, 5, 6, 7);
                        o[db] = __builtin_amdgcn_mfma_f32_32x32x16_bf16(vf, pf, o[db], 0, 0, 0); }
                }
            if (kt < c) AT_STORE((kt + 1) & 1);
            __syncthreads();
        }
#undef AT_LOAD
#undef AT_STORE
        { const float inv = 1.0f / l_run; bf16_t* optr = CTX + tq * 1024 + h * 128 + 4 * hh;
#pragma unroll
          for (int db = 0; db < 4; ++db)
#pragma unroll
              for (int gq = 0; gq < 4; ++gq) { u32x2 w; w.x = pk2(o[db][4 * gq] * inv, o[db][4 * gq + 1] * inv); w.y = pk2(o[db][4 * gq + 2] * inv, o[db][4 * gq + 3] * inv); *(u32x2*)(optr + db * 32 + 8 * gq) = w; } }
    }
}

__device__ __forceinline__ void conv_pass(const bf16_t* __restrict__ z, bf16_t* __restrict__ ff, const float* __restrict__ cw, const float* __restrict__ cb, int G, int bid) {
    const int gtid = bid * 512 + tid_opaque(), gsz = G * 512;
    constexpr int RUN = 8, NTASK = (TS / RUN) * 352;
    for (int id = gtid; id < NTASK; id += gsz) {
        const int run = id / 352, ch = id - run * 352, uu = ch >> 4, j0 = (ch & 15) * 8, colv = 128 * uu + j0, colg = DFF + colv, tok0 = run * RUN, s0 = tok0 & (SEQ - 1);
        const bf16_t* zp = z + (size_t)tok0 * NUP + 256 * uu + j0;
        u32x4 zv[RUN + 2], zg[RUN + 2];
#pragma unroll
        for (int i = 0; i < RUN + 2; ++i) { const int d = i - 2;
            if (s0 + d >= 0) { zv[i] = *(const u32x4*)(zp + (ptrdiff_t)d * NUP); zg[i] = *(const u32x4*)(zp + (ptrdiff_t)d * NUP + 128); } else { zv[i] = (u32x4){0u, 0u, 0u, 0u}; zg[i] = (u32x4){0u, 0u, 0u, 0u}; } }
        float wv[3][8], wg[3][8], bv[8], bg[8];
#pragma unroll
        for (int k = 0; k < 3; ++k) { const f32x4 a = *(const f32x4*)(cw + k * NUP + colv), b = *(const f32x4*)(cw + k * NUP + colv + 4), c = *(const f32x4*)(cw + k * NUP + colg), d = *(const f32x4*)(cw + k * NUP + colg + 4);
#pragma unroll
            for (int e = 0; e < 4; ++e) { wv[k][e] = a[e]; wv[k][4 + e] = b[e]; wg[k][e] = c[e]; wg[k][4 + e] = d[e]; } }
        { const f32x4 a = *(const f32x4*)(cb + colv), b = *(const f32x4*)(cb + colv + 4), c = *(const f32x4*)(cb + colg), d = *(const f32x4*)(cb + colg + 4);
#pragma unroll
          for (int e = 0; e < 4; ++e) { bv[e] = a[e]; bv[4 + e] = b[e]; bg[e] = c[e]; bg[4 + e] = d[e]; } }
        LOADS_DONE();
        float v2[8], v1[8], g2[8], g1[8];
        unpack8(zv[0], v2); unpack8(zv[1], v1); unpack8(zg[0], g2); unpack8(zg[1], g1);
#pragma unroll
        for (int r = 0; r < RUN; ++r) { float v0[8], g0[8], o[8]; unpack8(zv[r + 2], v0); unpack8(zg[r + 2], g0);
#pragma unroll
            for (int e = 0; e < 8; ++e) { const float vc = bv[e] + wv[0][e] * v2[e] + wv[1][e] * v1[e] + wv[2][e] * v0[e], gc = bg[e] + wg[0][e] * g2[e] + wg[1][e] * g1[e] + wg[2][e] * g0[e];
                o[e] = gc * pg8::sigm(gc) * vc; v2[e] = v1[e]; v1[e] = v0[e]; g2[e] = g1[e]; g1[e] = g0[e]; }
            u32x4 w; w.x = pk2(o[0], o[1]); w.y = pk2(o[2], o[3]); w.z = pk2(o[4], o[5]); w.w = pk2(o[6], o[7]);
            *(u32x4*)(ff + (size_t)(tok0 + r) * DFF + colv) = w; }
    }
}

__device__ __forceinline__ void conv_fix(const float* __restrict__ zb, bf16_t* __restrict__ ff, const float* __restrict__ cw, const float* __restrict__ cb, int G, int bid) {
    const int gtid = bid * 512 + tid_opaque(), gsz = G * 512;
    for (int id = gtid; id < (TS / 64) * 352; id += gsz) {
        const int gi = id / 352, ch = id - gi * 352, uu = ch >> 4, j0 = (ch & 15) * 8, colv = 128 * uu + j0, colg = DFF + colv, zc = 256 * uu + j0;
        const bool hasprev = (gi & 31) != 0;
        float zv[4][8], zg[4][8];
#pragma unroll
        for (int r = 0; r < 4; ++r) {
            const float* zp = zb + ((size_t)(r < 2 ? gi - 1 : gi) * 4 + (r < 2 ? 2 + r : r - 2)) * NUP + zc;
            if (r >= 2 || hasprev) { const f32x4 a = *(const f32x4*)zp, b = *(const f32x4*)(zp + 4), c = *(const f32x4*)(zp + 128), d = *(const f32x4*)(zp + 132);
#pragma unroll
                for (int e = 0; e < 4; ++e) { zv[r][e] = a[e]; zv[r][4 + e] = b[e]; zg[r][e] = c[e]; zg[r][4 + e] = d[e]; } }
            else {
#pragma unroll
                for (int e = 0; e < 8; ++e) { zv[r][e] = 0.f; zg[r][e] = 0.f; } } }
        float wv[3][8], wg[3][8], bv[8], bg[8];
#pragma unroll
        for (int k = 0; k < 3; ++k) { const f32x4 a = *(const f32x4*)(cw + k * NUP + colv), b = *(const f32x4*)(cw + k * NUP + colv + 4), c = *(const f32x4*)(cw + k * NUP + colg), d = *(const f32x4*)(cw + k * NUP + colg + 4);
#pragma unroll
            for (int e = 0; e < 4; ++e) { wv[k][e] = a[e]; wv[k][4 + e] = b[e]; wg[k][e] = c[e]; wg[k][4 + e] = d[e]; } }
        { const f32x4 a = *(const f32x4*)(cb + colv), b = *(const f32x4*)(cb + colv + 4), c = *(const f32x4*)(cb + colg), d = *(const f32x4*)(cb + colg + 4);
#pragma unroll
          for (int e = 0; e < 4; ++e) { bv[e] = a[e]; bv[4 + e] = b[e]; bg[e] = c[e]; bg[4 + e] = d[e]; } }
        LOADS_DONE();
#pragma unroll
        for (int r = 0; r < 2; ++r) { float o[8];
#pragma unroll
            for (int e = 0; e < 8; ++e) { const float vc = bv[e] + wv[0][e] * zv[r][e] + wv[1][e] * zv[r + 1][e] + wv[2][e] * zv[r + 2][e], gc = bg[e] + wg[0][e] * zg[r][e] + wg[1][e] * zg[r + 1][e] + wg[2][e] * zg[r + 2][e];
                o[e] = gc * pg8::sigm(gc) * vc; }
            u32x4 w; w.x = pk2(o[0], o[1]); w.y = pk2(o[2], o[3]); w.z = pk2(o[4], o[5]); w.w = pk2(o[6], o[7]);
            *(u32x4*)(ff + (size_t)(gi * 64 + r) * DFF + colv) = w; }
    }
}

__global__ void __launch_bounds__(512, 2) mega_fwd(Params p_unused) {
    extern __shared__ __attribute__((aligned(16))) unsigned char lds_raw[];
    LAS unsigned char* lds = (LAS unsigned char*)lds_raw;
    cg::grid_group grid = cg::this_grid();
    (void)p_unused;
    if (threadIdx.x < 2) ((LAS unsigned*)(lds + LDS_BARST))[threadIdx.x] = 0u;
    __syncthreads();
    { KPtr p0 = kparams(); (void)xcd_barrier_post((unsigned*)(p0->ws + OFF_BAR), (volatile LAS unsigned*)(lds + LDS_BARST)); }
#define GSYNC() do { KPtr pb_ = kparams(); XcdBarrier xb_; xb_.bar = (unsigned*)(pb_->ws + OFF_BAR); xb_.x = xb_xcc_id(); xb_.st = (volatile LAS unsigned*)(lds + LDS_BARST); xcd_barrier(xb_); } while (0)
#ifdef PROBE_MASK
    unsigned long long t_prev = __builtin_amdgcn_s_memrealtime(), t_acc = 0ull;
#define STAMP(cls) do { const unsigned long long t_ = __builtin_amdgcn_s_memrealtime(); if ((PROBE_MASK >> (cls)) & 1) t_acc += t_ - t_prev; t_prev = t_; } while (0)
#else
#define STAMP(cls) do { } while (0)
#endif
#define PH_BEGIN KPtr p = kparams(); int G = (int)gridDim.x, bid = (int)blockIdx.x; asm volatile("" : "+s"(G), "+s"(bid)); unsigned char* ws = p->ws; (void)ws;
    { PH_BEGIN prep_phase(p, lds, G, bid); }
    grid.sync(); STAMP(0);
    for (int sl = 0; sl < NS; ++sl) {
        const int tok0 = sl * TS;
        { PH_BEGIN const float* MOD = (const float*)(ws + OFF_MOD);
          ln_pass<0, true>(p->x, nullptr, nullptr, nullptr, (bf16_t*)(ws + OFF_H), tok0, nullptr, nullptr, MOD + 0, MOD + 1024, G, bid); }
        GSYNC(); STAMP(7);
        for (int l = 0; l < 2; ++l) {
            { PH_BEGIN const unsigned char* wl = ws + OFF_WL + (size_t)l * WL_STRIDE;
              pg8::Gemm g{(const bf16_t*)(ws + OFF_H), (const bf16_t*)(wl + WO_W1), TS, N1, 1024}; pg8::StaticOrder S; S.init(TS, N1, G, bid);
              pg8::Epi1 E{(bf16_t*)(ws + OFF_GATES), (bf16_t*)(ws + OFF_APOOL), (bf16_t*)(ws + OFF_UV), (float*)(ws + OFF_RAW)};
              pg8::gemm_phase<pg8::Epi1, pg8::StaticOrder, true, true>(lds, g, S, E); }
            GSYNC(); STAMP(1);
            { PH_BEGIN pool_pass((const bf16_t*)(ws + OFF_APOOL), (bf16_t*)(ws + OFF_BR), G, bid); }
            { PH_BEGIN
              norm_pass((const float*)(ws + OFF_RAW), (bf16_t*)(ws + OFF_CQN), (bf16_t*)(ws + OFF_K192), (bf16_t*)(ws + OFF_VT), p->g_q + l * 256, p->g_kv + l * 128, (const float*)(ws + OFF_COS), (const float*)(ws + OFF_SIN), tok0, lds, G, bid); }
            { PH_BEGIN
              sgu_pass((const bf16_t*)(ws + OFF_UV), (bf16_t*)(ws + OFF_BR) + (size_t)2 * TS * 1024, (const bf16_t*)(ws + OFF_WSB) + (size_t)l * 8 * 128 * 128, p->b_s + l * 1024, p->g_sg + l * 1024, p->b_sg + l * 1024, lds, G, bid); }
            GSYNC(); STAMP(2);
            { PH_BEGIN const unsigned char* wl = ws + OFF_WL + (size_t)l * WL_STRIDE;
              int kq = 256; asm volatile("" : "+s"(kq));
              pg8::Gemm g{(const bf16_t*)(ws + OFF_CQN), (const bf16_t*)(wl + WO_WQ), TS, NQ, kq}; pg8::StaticOrder S; S.init(TS, NQ, G, bid);
              pg8::EpiQ E{(bf16_t*)(ws + OFF_QP), (const float*)(ws + OFF_COS), (const float*)(ws + OFF_SIN), tok0};
              pg8::gemm_phase<pg8::EpiQ, pg8::StaticOrder, true, true>(lds, g, S, E); }
            GSYNC(); STAMP(3);
            { PH_BEGIN
              attn_phase(lds, (const bf16_t*)(ws + OFF_QP), (const bf16_t*)(ws + OFF_K192), (const bf16_t*)(ws + OFF_VT), (bf16_t*)(ws + OFF_BR) + (size_t)TS * 1024, G, bid); }
            GSYNC(); STAMP(4);
            { PH_BEGIN const unsigned char* wl = ws + OFF_WL + (size_t)l * WL_STRIDE;
              pg8::Gemm g{(const bf16_t*)(ws + OFF_BR), (const bf16_t*)(wl + WO_WBR), 3 * TS, 3 * 1024, 1024}; pg8::BrOrder S; S.init(TS, G, bid);
              pg8::EpiBr E{(const bf16_t*)(ws + OFF_GATES), (bf16_t*)(ws + OFF_H), TS / 256};
              pg8::gemm_phase<pg8::EpiBr, pg8::BrOrder, true, true>(lds, g, S, E); }
            GSYNC(); STAMP(5);
            { PH_BEGIN const unsigned char* wl = ws + OFF_WL + (size_t)l * WL_STRIDE;
              pg8::Gemm g{(const bf16_t*)(ws + OFF_H), (const bf16_t*)(wl + WO_WO), TS, 1024, 1024}; pg8::StaticOrder S; S.init(TS, 1024, G, bid);
              pg8::EpiUp E{(bf16_t*)(ws + OFF_Y), 1024};
              pg8::gemm_phase<pg8::EpiUp, pg8::StaticOrder, true, true>(lds, g, S, E); }
            GSYNC(); STAMP(6);
            { PH_BEGIN const float* modl = (const float*)(ws + OFF_MOD) + (size_t)l * 32 * 6144;
              ln_pass<1, true>((l == 0) ? p->x : (const float*)p->out, (const bf16_t*)(ws + OFF_Y), modl + 2048, p->out, (bf16_t*)(ws + OFF_H), tok0, p->ln_t_g + l * 1024, p->ln_t_b + l * 1024, modl + 3072, modl + 4096, G, bid); }
            GSYNC(); STAMP(7);
            { PH_BEGIN const unsigned char* wl = ws + OFF_WL + (size_t)l * WL_STRIDE;
              pg8::Gemm g{(const bf16_t*)(ws + OFF_H), (const bf16_t*)(wl + WO_WUP), TS, NUP, 1024}; pg8::StaticOrder S; S.init(TS, NUP, G, bid);
              pg8::EpiUpConv E{(bf16_t*)(ws + OFF_FF), (float*)(ws + OFF_Z), p->conv_w + (size_t)l * 3 * NUP, p->conv_b + (size_t)l * NUP};
              pg8::gemm_phase<pg8::EpiUpConv, pg8::StaticOrder, true, true>(lds, g, S, E); }
            GSYNC(); STAMP(8);
            { PH_BEGIN conv_fix((const float*)(ws + OFF_Z), (bf16_t*)(ws + OFF_FF), p->conv_w + (size_t)l * 3 * NUP, p->conv_b + (size_t)l * NUP, G, bid); }
            GSYNC(); STAMP(9);
            { PH_BEGIN const unsigned char* wl = ws + OFF_WL + (size_t)l * WL_STRIDE;
              pg8::Gemm g{(const bf16_t*)(ws + OFF_FF), (const bf16_t*)(wl + WO_WDN), TS, 1024, DFF}; pg8::StaticOrder S; S.init(TS, 1024, G, bid); pg8::EpiUp E{(bf16_t*)(ws + OFF_Y), 1024};
              pg8::gemm_phase<pg8::EpiUp, pg8::StaticOrder, true, true>(lds, g, S, E); }
            GSYNC(); STAMP(10);
            { PH_BEGIN const float* modl = (const float*)(ws + OFF_MOD) + (size_t)l * 32 * 6144; const float* mod1 = (const float*)(ws + OFF_MOD) + (size_t)32 * 6144;
              if (l == 0) ln_pass<1, true>(p->out, (const bf16_t*)(ws + OFF_Y), modl + 5120, p->out, (bf16_t*)(ws + OFF_H), tok0, p->ln_f_g, p->ln_f_b, mod1, mod1 + 1024, G, bid);
              else ln_pass<1, false>(p->out, (const bf16_t*)(ws + OFF_Y), modl + 5120, p->out, nullptr, tok0, p->ln_f_g + 1024, p->ln_f_b + 1024, nullptr, nullptr, G, bid); }
            GSYNC(); STAMP(7);
        }
    }
#ifdef PROBE_MASK
    { PH_BEGIN (void)G; if (bid == 0) { unsigned long long us = t_acc / 100ull; if (us > 20000ull) us = 20000ull; for (int i = tid_opaque(); i < (int)us; i += 512) p->out[i] += 0.1f; } }
#endif
}

extern "C" void kernel_launch(void* const* d_in, const int* in_sizes, int n_in, void* d_out, int out_size, void* d_ws, size_t ws_size, hipStream_t stream) {
    static int grid = 0;
    if (grid == 0) {
        if (n_in != 26 || ws_size < WS_NEED) { fprintf(stderr, "kernel_launch: unexpected n_in %d / ws_size %zu\n", n_in, ws_size); grid = -1; return; }
        int dev = 0, cus = 0, per_cu = 0;
        if (hipGetDevice(&dev) != hipSuccess || hipDeviceGetAttribute(&cus, hipDeviceAttributeMultiprocessorCount, dev) != hipSuccess) { grid = -1; return; }
        if (hipFuncSetAttribute((const void*)mega_fwd, hipFuncAttributeMaxDynamicSharedMemorySize, LDS_BYTES) != hipSuccess) { fprintf(stderr, "kernel_launch: hipFuncSetAttribute failed\n"); grid = -1; return; }
        if (hipOccupancyMaxActiveBlocksPerMultiprocessor(&per_cu, (const void*)mega_fwd, 512, LDS_BYTES) != hipSuccess || per_cu < 1) { fprintf(stderr, "kernel_launch: occupancy query says %d\n", per_cu); per_cu = 1; }
        (void)hipGetLastError();
        grid = cus;
    }
    if (grid < 0) return;
    Params p{};
    const float** pf = (const float**)&p;
    p.x = (const float*)d_in[0]; p.c = (const float*)d_in[1]; p.pos = (const int*)d_in[2]; p.w_ada = (const float*)d_in[3]; p.b_ada = (const float*)d_in[4]; p.w_in = (const float*)d_in[5];
    p.w_pool = (const float*)d_in[6]; p.s_pool = (const float*)d_in[7]; p.g_q = (const float*)d_in[8]; p.w_uq = (const float*)d_in[9]; p.g_kv = (const float*)d_in[10]; p.w_ukv = (const float*)d_in[11];
    p.g_sg = (const float*)d_in[12]; p.b_sg = (const float*)d_in[13]; p.w_s = (const float*)d_in[14]; p.b_s = (const float*)d_in[15]; p.w_branch = (const float*)d_in[16]; p.w_o = (const float*)d_in[17];
    p.ln_t_g = (const float*)d_in[18]; p.ln_t_b = (const float*)d_in[19]; p.w_up = (const float*)d_in[20]; p.conv_w = (const float*)d_in[21]; p.conv_b = (const float*)d_in[22]; p.w_down = (const float*)d_in[23];
    p.ln_f_g = (const float*)d_in[24]; p.ln_f_b = (const float*)d_in[25];
    (void)pf;
    p.out = (float*)d_out; p.ws = (unsigned char*)d_ws;
    if (hipMemsetAsync((unsigned char*)d_ws + OFF_BAR, 0, BAR_BYTES, stream) != hipSuccess) { fprintf(stderr, "kernel_launch: memset failed\n"); return; }
    void* args[] = {&p};
    const hipError_t e = hipLaunchCooperativeKernel((const void*)mega_fwd, dim3(grid), dim3(512), args, LDS_BYTES, stream);
    if (e != hipSuccess) fprintf(stderr, "kernel_launch: cooperative launch failed: %s (grid %d)\n", hipGetErrorString(e), grid);
}
```
